# Optimizing an MI355X kernel written in HIP

```python
import jax, jax.numpy as jnp
from jax import lax
import numpy as np

D_MODEL = 1024
BATCH = 4
SEQ = 4096
DEPTH = 2
DEC_BATCH = 8
DEC_SEQ = 16
PAST_LEN = 2048

CHUNK = 64
Q_BLOCK = 128
N_MEM = 256

MLA_HEADS = 4
MLA_NOPE = 128
MLA_ROPE = 64
MLA_V = 128
MLA_Q_RANK = 384
MLA_KV_RANK = 256
MLA_WIDTH = MLA_HEADS * MLA_V
FOX_HEADS = 4
FOX_DIM = 64
FOX_WIDTH = FOX_HEADS * FOX_DIM
MEM_HEADS = 4
MEM_DIM = 64
MEM_WIDTH = MEM_HEADS * MEM_DIM
D_MIX = MLA_WIDTH + FOX_WIDTH + MEM_WIDTH

ROPE_THETA = 10000.0
NORM_EPS = 1e-6
NEG_INF = -1e30
MLA_SCALE = (MLA_NOPE + MLA_ROPE) ** -0.5
FOX_SCALE = FOX_DIM ** -0.5
MEM_SCALE = MEM_DIM ** -0.5
DEEPNORM_ALPHA = (2 * DEPTH) ** 0.25
DEEPNORM_BETA = (8 * DEPTH) ** -0.25

IN_SPLITS = (MLA_Q_RANK, MLA_KV_RANK, MLA_ROPE, MLA_WIDTH,
             FOX_WIDTH, FOX_WIDTH, FOX_WIDTH, FOX_HEADS, FOX_WIDTH,
             MEM_WIDTH, MEM_WIDTH)
D_IN = sum(IN_SPLITS)

kernel_name = 'hybrid_mla_fox_mem_streaming_step'


def _rms_norm(x, g):
    xf = x.astype(jnp.float32)
    y = xf * lax.rsqrt(jnp.mean(xf * xf, axis=-1, keepdims=True) + NORM_EPS)
    return (y * g.astype(jnp.float32)).astype(x.dtype)


def _layer_norm(x, g, b):
    xf = x.astype(jnp.float32)
    mu = jnp.mean(xf, axis=-1, keepdims=True)
    xc = xf - mu
    var = jnp.mean(xc * xc, axis=-1, keepdims=True)
    y = xc * lax.rsqrt(var + NORM_EPS) * g.astype(jnp.float32) + b.astype(jnp.float32)
    return y.astype(x.dtype)


def _rope(x, pos):
    half = x.shape[-1] // 2
    inv = ROPE_THETA ** (-jnp.arange(half, dtype=jnp.float32) / half)
    ang = pos.astype(jnp.float32)[:, None] * inv[None, :]
    shape = (1, pos.shape[0]) + (1,) * (x.ndim - 3) + (half,)
    cos = jnp.cos(ang).reshape(shape)
    sin = jnp.sin(ang).reshape(shape)
    x1 = x[..., :half].astype(jnp.float32)
    x2 = x[..., half:].astype(jnp.float32)
    return jnp.concatenate([x1 * cos - x2 * sin, x1 * sin + x2 * cos], axis=-1).astype(x.dtype)


def _attend(q, k, v, q_pos, k_pos, scale, chunk_causal, cq=None, ck=None):
    B, Tq, H, _ = q.shape
    Dv = v.shape[-1]
    k_idx = k_pos // CHUNK if chunk_causal else k_pos
    ck_t = None if ck is None else jnp.transpose(ck, (0, 2, 1))

    def block(args):
        qb, pb, cqb = args
        s = jnp.einsum('bqhd,bkhd->bhqk', qb, k).astype(jnp.float32) * scale
        if cqb is not None:
            s = s + (jnp.transpose(cqb, (0, 2, 1))[:, :, :, None] - ck_t[:, :, None, :])
        q_idx = pb // CHUNK if chunk_causal else pb
        allowed = k_idx[None, :] <= q_idx[:, None]
        s = jnp.where(allowed[None, None], s, NEG_INF)
        p = jax.nn.softmax(s, axis=-1).astype(v.dtype)
        return jnp.einsum('bhqk,bkhd->bqhd', p, v)

    if Tq > Q_BLOCK and Tq % Q_BLOCK == 0:
        nb = Tq // Q_BLOCK
        qs = jnp.transpose(q.reshape(B, nb, Q_BLOCK, H, q.shape[-1]), (1, 0, 2, 3, 4))
        ps = q_pos.reshape(nb, Q_BLOCK)
        cs = None if cq is None else jnp.transpose(cq.reshape(B, nb, Q_BLOCK, H), (1, 0, 2, 3))
        out = lax.map(block, (qs, ps, cs))
        return jnp.transpose(out, (1, 0, 2, 3, 4)).reshape(B, Tq, H, Dv)
    return block((q, q_pos, cq))


def _mem_kv(mem, w_mem_kv):
    B, M, _ = mem.shape
    kv = jnp.einsum('bmd,de->bme', mem, w_mem_kv)
    mk = kv[..., :MEM_WIDTH].reshape(B, M, MEM_HEADS, MEM_DIM)
    mv = kv[..., MEM_WIDTH:].reshape(B, M, MEM_HEADS, MEM_DIM)
    return mk, mv


def _layer(x, pos, mem_k, mem_v, past, w_in, b_f, q_norm_g, kv_norm_g, w_uq, w_ukv, w_out, ln_g, ln_b):
    B, T, _ = x.shape
    h = jnp.einsum('btd,de->bte', x, w_in)
    split_idx = np.cumsum(IN_SPLITS)[:-1].tolist()
    (c_q, c_kv, k_rope, g_mla, f_q, f_k, f_v, f_logit, g_fox, m_q, g_mem) = jnp.split(h, split_idx, axis=-1)

    q = jnp.einsum('btr,re->bte', _rms_norm(c_q, q_norm_g), w_uq).reshape(B, T, MLA_HEADS, MLA_NOPE + MLA_ROPE)
    q = jnp.concatenate([q[..., :MLA_NOPE], _rope(q[..., MLA_NOPE:], pos)], axis=-1)
    lat_new = _rms_norm(c_kv, kv_norm_g)
    kr_new = _rope(k_rope, pos)

    fq = f_q.reshape(B, T, FOX_HEADS, FOX_DIM)
    fk_new = f_k.reshape(B, T, FOX_HEADS, FOX_DIM)
    fv_new = f_v.reshape(B, T, FOX_HEADS, FOX_DIM)
    logf_new = jax.nn.log_sigmoid(f_logit.astype(jnp.float32) + b_f.astype(jnp.float32))

    if past is None:
        lat, kr, fk, fv, logf, k_pos = lat_new, kr_new, fk_new, fv_new, logf_new, pos
    else:
        p_lat, p_kr, p_fk, p_fv, p_logf = past
        lat = jnp.concatenate([p_lat, lat_new], axis=1)
        kr = jnp.concatenate([p_kr, kr_new], axis=1)
        fk = jnp.concatenate([p_fk, fk_new], axis=1)
        fv = jnp.concatenate([p_fv, fv_new], axis=1)
        logf = jnp.concatenate([p_logf.astype(jnp.float32), logf_new], axis=1)
        k_pos = jnp.arange(lat.shape[1])
    Tk = lat.shape[1]

    kv = jnp.einsum('btr,re->bte', lat, w_ukv).reshape(B, Tk, MLA_HEADS, MLA_NOPE + MLA_V)
    k_mla = jnp.concatenate([kv[..., :MLA_NOPE],
                             jnp.broadcast_to(kr[:, :, None, :], (B, Tk, MLA_HEADS, MLA_ROPE))], axis=-1)
    o_mla = _attend(q, k_mla, kv[..., MLA_NOPE:], pos, k_pos, MLA_SCALE, True)

    cum = jnp.cumsum(logf, axis=1)
    o_fox = _attend(fq, fk, fv, pos, k_pos, FOX_SCALE, False, cum[:, Tk - T:], cum)

    mq = m_q.reshape(B, T, MEM_HEADS, MEM_DIM)
    s_mem = jnp.einsum('bthd,bmhd->bhtm', mq, mem_k).astype(jnp.float32) * MEM_SCALE
    o_mem = jnp.einsum('bhtm,bmhd->bthd', jax.nn.softmax(s_mem, axis=-1).astype(mem_v.dtype), mem_v)

    mixed = jnp.concatenate([o_mla.reshape(B, T, MLA_WIDTH) * jax.nn.silu(g_mla),
                             o_fox.reshape(B, T, FOX_WIDTH) * jax.nn.silu(g_fox),
                             o_mem.reshape(B, T, MEM_WIDTH) * jax.nn.silu(g_mem)], axis=-1)
    out = jnp.einsum('bte,ed->btd', mixed, w_out)
    y = _layer_norm(DEEPNORM_ALPHA * x + out, ln_g, ln_b)
    return y, (lat_new, kr_new, fk_new, fv_new, logf_new)


def setup_inputs(seed: int = 0) -> dict:
    key = jax.random.key(seed)
    ks = jax.random.split(key, 24)
    f32 = jnp.float32
    nrm = lambda k, shape: jax.random.normal(k, shape, dtype=f32)
    return {
        'x_prompt': nrm(ks[0], (BATCH, SEQ, D_MODEL)),
        'x_sample': nrm(ks[1], (DEC_BATCH, DEC_SEQ, D_MODEL)),
        'cache_mla_latent': nrm(ks[2], (DEPTH, DEC_BATCH, PAST_LEN, MLA_KV_RANK)),
        'cache_mla_krope': nrm(ks[3], (DEPTH, DEC_BATCH, PAST_LEN, MLA_ROPE)),
        'cache_fox_k': nrm(ks[4], (DEPTH, DEC_BATCH, PAST_LEN, FOX_HEADS, FOX_DIM)),
        'cache_fox_v': nrm(ks[5], (DEPTH, DEC_BATCH, PAST_LEN, FOX_HEADS, FOX_DIM)),
        'cache_fox_logf': jax.nn.log_sigmoid(3.0 + nrm(ks[6], (DEPTH, DEC_BATCH, PAST_LEN, FOX_HEADS))),
        'cache_mem_k': nrm(ks[7], (DEPTH, DEC_BATCH, N_MEM, MEM_HEADS, MEM_DIM)),
        'cache_mem_v': nrm(ks[8], (DEPTH, DEC_BATCH, N_MEM, MEM_HEADS, MEM_DIM)),
        'mem_prompt': nrm(ks[9], (BATCH, N_MEM, D_MODEL)),
        'w_in': nrm(ks[10], (DEPTH, D_MODEL, D_IN)) * D_MODEL ** -0.5,
        'b_fox_f': 3.0 + 0.5 * nrm(ks[11], (DEPTH, FOX_HEADS)),
        'mla_q_norm': 1.0 + 0.01 * nrm(ks[12], (DEPTH, MLA_Q_RANK)),
        'mla_kv_norm': 1.0 + 0.01 * nrm(ks[13], (DEPTH, MLA_KV_RANK)),
        'w_uq': nrm(ks[14], (DEPTH, MLA_Q_RANK, MLA_HEADS * (MLA_NOPE + MLA_ROPE))) * MLA_Q_RANK ** -0.5,
        'w_ukv': nrm(ks[15], (DEPTH, MLA_KV_RANK, MLA_HEADS * (MLA_NOPE + MLA_V))) * MLA_KV_RANK ** -0.5,
        'w_mem_kv': nrm(ks[16], (DEPTH, D_MODEL, 2 * MEM_WIDTH)) * D_MODEL ** -0.5,
        'w_out': nrm(ks[17], (DEPTH, D_MIX, D_MODEL)) * (D_MIX ** -0.5 * DEEPNORM_BETA),
        'ln_g': 1.0 + 0.01 * nrm(ks[18], (DEPTH, D_MODEL)),
        'ln_b': 0.01 * nrm(ks[19], (DEPTH, D_MODEL)),
    }


def reference(x_prompt, x_sample, cache_mla_latent, cache_mla_krope, cache_fox_k, cache_fox_v, cache_fox_logf,
              cache_mem_k, cache_mem_v, mem_prompt, w_in, b_fox_f, mla_q_norm, mla_kv_norm, w_uq, w_ukv,
              w_mem_kv, w_out, ln_g, ln_b):
    past_len = cache_mla_latent.shape[2]
    pos_p = jnp.arange(x_prompt.shape[1])
    pos_s = past_len + jnp.arange(x_sample.shape[1])
    yp, ys = x_prompt, x_sample
    p_rows, s_rows, p_mk, p_mv = [], [], [], []
    for l in range(DEPTH):
        weights = (w_in[l], b_fox_f[l], mla_q_norm[l], mla_kv_norm[l], w_uq[l], w_ukv[l], w_out[l], ln_g[l], ln_b[l])
        mk, mv = _mem_kv(mem_prompt, w_mem_kv[l])
        yp, rp = _layer(yp, pos_p, mk, mv, None, *weights)
        past = (cache_mla_latent[l], cache_mla_krope[l], cache_fox_k[l], cache_fox_v[l], cache_fox_logf[l])
        ys, rs = _layer(ys, pos_s, cache_mem_k[l], cache_mem_v[l], past, *weights)
        p_rows.append(rp)
        s_rows.append(rs)
        p_mk.append(mk)
        p_mv.append(mv)
    p_lat, p_kr, p_fk, p_fv, p_logf = [jnp.stack([r[i] for r in p_rows], axis=0) for i in range(5)]
    s_lat, s_kr, s_fk, s_fv, s_logf = [jnp.stack([r[i] for r in s_rows], axis=0) for i in range(5)]
    p_mem_k = jnp.stack(p_mk, axis=0)
    p_mem_v = jnp.stack(p_mv, axis=0)
    return (yp, ys, p_lat, p_kr, p_fk, p_fv, p_logf, p_mem_k, p_mem_v, s_lat, s_kr, s_fk, s_fv, s_logf)
```

```cpp
#include <hip/hip_runtime.h>
#include <hip/hip_cooperative_groups.h>
#include <cstdio>
#include <cstdint>
namespace cg = cooperative_groups;

#ifndef PROBE_KIND
#define PROBE_KIND -1
#endif
#ifndef MK_LAUNCHES
#define MK_LAUNCHES 1
#endif

#define DI __device__ __forceinline__
typedef unsigned short u16;
typedef __attribute__((ext_vector_type(8))) short bf16x8;
typedef __attribute__((ext_vector_type(4))) short s16x4;
typedef __attribute__((ext_vector_type(16))) float f32x16;
typedef __attribute__((ext_vector_type(2))) __bf16 bf2_t;
typedef unsigned u32x4 __attribute__((ext_vector_type(4)));
typedef float f32x4 __attribute__((ext_vector_type(4)));
#define MFMA(a, b, c) __builtin_amdgcn_mfma_f32_32x32x16_bf16((a), (b), (c), 0, 0, 0)

constexpr int D = 1024, BP = 4, TP = 4096, BS = 8, TS = 16, PAST = 2048;
constexpr int MP = BP * TP;
constexpr int MS = BS * TS;
constexpr int MT = MP + MS;
constexpr int TKS = PAST + TS;
constexpr int TAS = 2112;
constexpr int DIN = 2756, N1 = 2816;
constexpr int NMEM = 256;
constexpr float LOG2E = 1.4426950408889634f;
constexpr float EPS = 1e-6f;
constexpr float ALPHA = 1.4142135623730951f;

constexpr int SEG_CQ = 0, SEG_CKV = 384, SEG_KR = 640, SEG_GMLA = 704, SEG_FQ = 1216, SEG_FK = 1472, SEG_FV = 1728,
              SEG_GFOX = 1984, SEG_MQ = 2240, SEG_GMEM = 2496, SEG_FL = 2752;

constexpr size_t O_Y = 0;
constexpr size_t O_PLAT = (size_t)MT * D;
constexpr size_t O_PKR = O_PLAT + (size_t)2 * MP * 256;
constexpr size_t O_PFK = O_PKR + (size_t)2 * MP * 64;
constexpr size_t O_PFV = O_PFK + (size_t)2 * MP * 256;
constexpr size_t O_PLOGF = O_PFV + (size_t)2 * MP * 256;
constexpr size_t O_PMK = O_PLOGF + (size_t)2 * MP * 4;
constexpr size_t O_PMV = O_PMK + (size_t)2 * BP * NMEM * 256;
constexpr size_t O_SLAT = O_PMV + (size_t)2 * BP * NMEM * 256;
constexpr size_t O_SKR = O_SLAT + (size_t)2 * MS * 256;
constexpr size_t O_SFK = O_SKR + (size_t)2 * MS * 64;
constexpr size_t O_SFV = O_SFK + (size_t)2 * MS * 256;
constexpr size_t O_SLOGF = O_SFV + (size_t)2 * MS * 256;
constexpr size_t O_TOTAL = O_SLOGF + (size_t)2 * MS * 4;
static_assert(O_TOTAL == 45564928, "output size");

constexpr size_t al256(size_t x) { return (x + 255) & ~(size_t)255; }
constexpr size_t BAR_BYTES = 32768;
constexpr size_t W_BAR = 0;
constexpr size_t W_TAB = W_BAR + BAR_BYTES;
constexpr size_t W_XB = W_TAB + (size_t)4096 * 32 * 8;
constexpr size_t W_GATE = W_XB + (size_t)MT * 1024 * 2;
constexpr size_t W_CQ = W_GATE + (size_t)(MT + 128) * 1088 * 2;
constexpr size_t W_CKV = W_CQ + (size_t)MT * 384 * 2;
constexpr size_t W_FQ = W_CKV + (size_t)MT * 256 * 2;
constexpr size_t W_MQ = W_FQ + (size_t)MT * 256 * 2;
constexpr size_t W_FKBP = W_MQ + (size_t)MT * 256 * 2;
constexpr size_t W_FVTP = W_FKBP + (size_t)MP * 256 * 2;
constexpr size_t W_KRBP = W_FVTP + (size_t)MP * 256 * 2;
constexpr size_t W_KNP = W_KRBP + (size_t)MP * 64 * 2;
constexpr size_t W_VTP = W_KNP + (size_t)16 * 4096 * 128 * 2;
constexpr size_t W_FKBS = W_VTP + (size_t)16 * 4096 * 128 * 2;
constexpr size_t W_FVTS = W_FKBS + (size_t)BS * TAS * 256 * 2;
constexpr size_t W_KRBS = W_FVTS + (size_t)BS * TAS * 256 * 2;
constexpr size_t W_KNS = W_KRBS + (size_t)BS * TAS * 64 * 2;
constexpr size_t W_VTS = W_KNS + (size_t)32 * TAS * 128 * 2;
constexpr size_t W_MEMKP = W_VTS + (size_t)32 * TAS * 128 * 2;
constexpr size_t W_MEMVTP = W_MEMKP + (size_t)2 * 1024 * 256 * 2;
constexpr size_t W_MEMKS = W_MEMVTP + (size_t)2 * 1024 * 256 * 2;
constexpr size_t W_MEMVTS = W_MEMKS + (size_t)2048 * 256 * 2;
constexpr size_t W_MEMB = W_MEMVTS + (size_t)2048 * 256 * 2;
constexpr size_t W_WIN = W_MEMB + (size_t)1024 * 1024 * 2;
constexpr size_t W_WUQ = W_WIN + (size_t)2 * N1 * 1024 * 2;
constexpr size_t W_WUKV = W_WUQ + (size_t)2 * 768 * 384 * 2;
constexpr size_t W_WUKVF = W_WUKV + (size_t)2 * 1024 * 256 * 2;
constexpr size_t W_WMKV = W_WUKVF + (size_t)2 * 1024 * 256 * 2;
constexpr size_t W_WOUT = W_WMKV + (size_t)2 * 512 * 1024 * 2;
constexpr size_t W_CUMP = W_WOUT + (size_t)2 * 1024 * 1088 * 2;
constexpr size_t W_CUMS = W_CUMP + (size_t)16 * 4096 * 4;
constexpr size_t W_LATC = W_CUMS + (size_t)32 * TAS * 4;
constexpr size_t W_END = W_LATC + (size_t)BS * PAST * 256 * 2;
static_assert(W_END <= (size_t)256 * 1024 * 1024, "workspace too large");

constexpr int GLD = 1088;
constexpr int NPH = 11;
constexpr int NTH = 512;

struct Params {
  const float* x_prompt; const float* x_sample;
  const float* c_lat; const float* c_kr; const float* c_fk; const float* c_fv; const float* c_logf;
  const float* c_mk; const float* c_mv;
  const float* mem_prompt; const float* w_in; const float* b_f; const float* qn_g; const float* kvn_g;
  const float* w_uq; const float* w_ukv; const float* w_memkv; const float* w_out; const float* ln_g; const float* ln_b;
  float* out; char* ws;
  int use_cg; int pad;
};

DI unsigned pk2(float a, float b) { bf2_t v; v[0] = (__bf16)a; v[1] = (__bf16)b; return __builtin_bit_cast(unsigned, v); }
DI void st4bf(u16* p, float a, float b, float c, float d) { *(uint2*)p = make_uint2(pk2(a, b), pk2(c, d)); }
DI float bflo(unsigned u) { return __uint_as_float(u << 16); }
DI float bfhi(unsigned u) { return __uint_as_float(u & 0xffff0000u); }
DI void st_quad_t(u16* p_tok0, float x, bool lead) {
  const float x1 = __int_as_float(__builtin_amdgcn_update_dpp(0, __float_as_int(x), 0x55, 0xf, 0xf, false));
  const float x2 = __int_as_float(__builtin_amdgcn_update_dpp(0, __float_as_int(x), 0xAA, 0xf, 0xf, false));
  const float x3 = __int_as_float(__builtin_amdgcn_update_dpp(0, __float_as_int(x), 0xFF, 0xf, 0xf, false));
  if (lead) *(uint2*)p_tok0 = make_uint2(pk2(x, x1), pk2(x2, x3));
}
DI float silu(float x) { return x / (1.f + __expf(-x)); }
DI float ex2(float x) { return __builtin_amdgcn_exp2f(x); }
DI float half_max(float v) { const auto r = __builtin_amdgcn_permlane32_swap(__float_as_uint(v), __float_as_uint(v), false, false); return fmaxf(__uint_as_float(r[0]), __uint_as_float(r[1])); }
DI float half_sum(float v) { const auto r = __builtin_amdgcn_permlane32_swap(__float_as_uint(v), __float_as_uint(v), false, false); return __uint_as_float(r[0]) + __uint_as_float(r[1]); }

DI int tid() { int t = threadIdx.x; asm volatile("" : "+v"(t)); return t; }

#define XB_TMO      128
#define XB_XCNT(j)  (256  + 64 * (j))
#define XB_XSUB(j)  (1280 + 64 * (j))
#define XB_XGEN(j)  (2304 + 64 * (j))
#define XB_TOP      3328
#define XB_TOPGEN   3392
#define XB_CTR(ph)  (4096 + 128 * (ph))
#define XB_SCNT(l)  (7680 + 64 * (l))
#define XB_SPIN_CAP (1u << 22)
#define LAS __attribute__((address_space(3)))
DI unsigned xb_ld(unsigned* p) { return __hip_atomic_load(p, __ATOMIC_RELAXED, __HIP_MEMORY_SCOPE_AGENT); }
DI unsigned xb_add(unsigned* p, unsigned v) { return __hip_atomic_fetch_add(p, v, __ATOMIC_RELAXED, __HIP_MEMORY_SCOPE_AGENT); }
DI unsigned xb_xcc_id() { return (unsigned)__builtin_amdgcn_s_getreg((3 << 11) | 20) & 0xFu; }
#define XB_SPIN(cond, bar) do { unsigned _sp = 0; while (cond) { __builtin_amdgcn_s_sleep(1); \
    if ((++_sp & 255u) == 0u) { if (xb_ld(&(bar)[XB_TMO])) break; if (_sp > XB_SPIN_CAP) { atomicAdd(&(bar)[XB_TMO], 1u); break; } } } } while (0)
struct XcdBarrier { unsigned* bar; unsigned x; volatile LAS unsigned* st; };
DI XcdBarrier xcd_barrier_post(unsigned* bar, volatile LAS unsigned* st) {
  XcdBarrier b; b.bar = bar; b.x = xb_xcc_id(); b.st = st;
  if (threadIdx.x == 0) (void)xb_add(&bar[XB_XCNT(b.x)], 1u);
  return b;
}
DI void xcd_barrier_complete(unsigned* bar, unsigned x, unsigned& nloc, unsigned& nx) {
  const unsigned G = gridDim.x * gridDim.y * gridDim.z;
  unsigned sum, cnt, mine, sp = 0u;
  for (;;) {
    sum = 0u; cnt = 0u; mine = 0u;
#pragma unroll
    for (unsigned j = 0; j < 16; ++j) { const unsigned c = xb_ld(&bar[XB_XCNT(j)]); sum += c; cnt += (c > 0u) ? 1u : 0u; mine = (j == x) ? c : mine; }
    if (sum == G) break;
    __builtin_amdgcn_s_sleep(1);
    if ((++sp & 255u) == 0u) { if (xb_ld(&bar[XB_TMO])) break; if (sp > XB_SPIN_CAP) { atomicAdd(&bar[XB_TMO], 1u); break; } }
  }
  nloc = mine > 0u ? mine : 1u; nx = cnt > 0u ? cnt : 1u;
}
DI void xcd_barrier(XcdBarrier b) {
  asm volatile("s_waitcnt vmcnt(0)" ::: "memory");
  __syncthreads();
  if (threadIdx.x == 0) {
    unsigned* bar = b.bar;
    asm volatile("" : "+s"(bar));
    b.x = xb_xcc_id();
    __builtin_amdgcn_s_waitcnt(0);
    unsigned nloc = b.st[0], nx = b.st[1];
    if (nloc == 0u) { xcd_barrier_complete(bar, b.x, nloc, nx); b.st[0] = nloc; b.st[1] = nx; }
    const unsigned old = xb_add(&bar[XB_XSUB(b.x)], 1u);
    const unsigned gen = old / nloc;
    if (old + 1u == (gen + 1u) * nloc) {
      __builtin_amdgcn_fence(__ATOMIC_RELEASE, "agent");
      asm volatile("s_waitcnt vmcnt(0)" ::: "memory");
      const unsigned og = xb_add(&bar[XB_TOP], 1u);
      const unsigned tg = og / nx;
      if (og + 1u == (tg + 1u) * nx) xb_add(&bar[XB_TOPGEN], 1u);
      else XB_SPIN(xb_ld(&bar[XB_TOPGEN]) == tg, bar);
      __builtin_amdgcn_fence(__ATOMIC_ACQUIRE, "agent");
      xb_add(&bar[XB_XGEN(b.x)], 1u);
      asm volatile("s_waitcnt vmcnt(0)" ::: "memory");
    } else {
      XB_SPIN(xb_ld(&bar[XB_XGEN(b.x)]) == gen, bar);
      __builtin_amdgcn_fence(__ATOMIC_ACQUIRE, "agent");
      asm volatile("s_waitcnt vmcnt(0)" ::: "memory");
    }
  }
  __syncthreads();
}

constexpr int LDT = 72;
constexpr int GEMM_BUF = 2 * 256 * LDT;
constexpr int SMEM_BYTES = 2 * GEMM_BUF * 2 + 1024;
DI int pop_item(unsigned* ctrs, int q, int* s_item) {
  __syncthreads();
  if (threadIdx.x == 0) *s_item = (int)atomicAdd(ctrs + q * 16, 1u);
  __syncthreads();
  return *s_item;
}
#define FOR_QUEUES(q, j, NQ_EXPR) \
  for (int qq_ = 0, x0_ = (int)(xb_xcc_id() & 7u); qq_ < 8; ++qq_) { const int q = (x0_ + qq_) & 7; const int nq_ = (NQ_EXPR); \
    for (;;) { const int j = pop_item(ctr, q, s_item); if (j >= nq_) break;
#define END_QUEUES }}
DI int q_mtiles(int q, int mtiles) { return (mtiles - q + 7) >> 3; }

DI int wi_colmap(int n) {
  if (n < 1984) return n;
  if (n < 2752) return n + 4;
  if (n < 2756) return 1984 + (n - 2752);
  return -1;
}
DI void transpose_w(const float* __restrict__ src, int Nsrc, u16* __restrict__ dst, int Npad, int K, bool permute,
                    const float* __restrict__ g, int gt, int nth, int ldd = 0) {
  if (ldd == 0) ldd = K;
  const int total = Npad * (K >> 3);
  for (int i = gt; i < total; i += nth) {
    const int n = i % Npad, k8 = i / Npad;
    const int on = permute ? wi_colmap(n) : n;
    float v[8];
#pragma unroll
    for (int j = 0; j < 8; ++j) {
      float x = (on >= 0) ? src[(size_t)(k8 * 8 + j) * Nsrc + on] : 0.f;
      if (g) x *= g[k8 * 8 + j];
      v[j] = x;
    }
    *(uint4*)(dst + (size_t)n * ldd + k8 * 8) = make_uint4(pk2(v[0], v[1]), pk2(v[2], v[3]), pk2(v[4], v[5]), pk2(v[6], v[7]));
  }
}
DI void convert8(const float* __restrict__ src, u16* __restrict__ dst) {
  const float4 a = ((const float4*)src)[0], b = ((const float4*)src)[1];
  *(uint4*)dst = make_uint4(pk2(a.x, a.y), pk2(a.z, a.w), pk2(b.x, b.y), pk2(b.z, b.w));
}

DI void phase_prep(const Params& p) {
  const int nth = gridDim.x * NTH, gt = blockIdx.x * NTH + tid();
  char* ws = p.ws;
  u16* Xb = (u16*)(ws + W_XB);
  for (int i = gt; i < MT * D / 8; i += nth) {
    const size_t e = (size_t)i * 8;
    const float* src = e < (size_t)MP * D ? p.x_prompt + e : p.x_sample + (e - (size_t)MP * D);
    convert8(src, Xb + e);
  }
  u16* memb = (u16*)(ws + W_MEMB);
  for (int i = gt; i < 1024 * 1024 / 8; i += nth) convert8(p.mem_prompt + (size_t)i * 8, memb + (size_t)i * 8);
  for (int l = 0; l < 2; ++l) {
    transpose_w(p.w_in + (size_t)l * D * DIN, DIN, (u16*)(ws + W_WIN) + (size_t)l * N1 * 1024, N1, 1024, true, nullptr, gt, nth);
    transpose_w(p.w_uq + (size_t)l * 384 * 768, 768, (u16*)(ws + W_WUQ) + (size_t)l * 768 * 384, 768, 384, false, p.qn_g + l * 384, gt, nth);
    transpose_w(p.w_ukv + (size_t)l * 256 * 1024, 1024, (u16*)(ws + W_WUKV) + (size_t)l * 1024 * 256, 1024, 256, false, nullptr, gt, nth);
    transpose_w(p.w_ukv + (size_t)l * 256 * 1024, 1024, (u16*)(ws + W_WUKVF) + (size_t)l * 1024 * 256, 1024, 256, false, p.kvn_g + l * 256, gt, nth);
    transpose_w(p.w_memkv + (size_t)l * 1024 * 512, 512, (u16*)(ws + W_WMKV) + (size_t)l * 512 * 1024, 512, 1024, false, nullptr, gt, nth);
    transpose_w(p.w_out + (size_t)l * 1024 * 1024, 1024, (u16*)(ws + W_WOUT) + (size_t)l * 1024 * GLD, 1024, 1024, false, nullptr, gt, nth, GLD);
  }
  float2* tab = (float2*)(ws + W_TAB);
  for (int i = gt; i < 4096 * 32; i += nth) {
    const int pos = i >> 5, c = i & 31;
    const float inv = powf(10000.f, -(float)c / 32.f);
    const float ang = (float)pos * inv;
    float s, co; sincosf(ang, &s, &co);
    tab[i] = make_float2(co, s);
  }
}

DI void phase_cacheconv(const Params& p, int l) {
  const int nth = gridDim.x * NTH, gt = blockIdx.x * NTH + tid();
  char* ws = p.ws;
  {
    const float* src = p.c_fk + (size_t)l * BS * PAST * 256; u16* dst = (u16*)(ws + W_FKBS);
    for (int i = gt; i < BS * PAST * 256 / 8; i += nth) {
      const int c8 = i & 31, bt = i >> 5, b = bt >> 11, t = bt & 2047;
      convert8(src + (size_t)i * 8, dst + ((size_t)(b * TAS + t) * 256 + c8 * 8));
    }
  }
  {
    const float* src = p.c_lat + (size_t)l * BS * PAST * 256; u16* dst = (u16*)(ws + W_LATC);
    for (int i = gt; i < BS * PAST * 256 / 8; i += nth) convert8(src + (size_t)i * 8, dst + (size_t)i * 8);
  }
  {
    const float* src = p.c_kr + (size_t)l * BS * PAST * 64; u16* dst = (u16*)(ws + W_KRBS);
    for (int i = gt; i < BS * PAST * 64 / 8; i += nth) {
      const int c8 = i & 7, bt = i >> 3, b = bt >> 11, t = bt & 2047;
      convert8(src + (size_t)i * 8, dst + ((size_t)(b * TAS + t) * 64 + c8 * 8));
    }
  }
  {
    const float* src = p.c_mk + (size_t)l * BS * NMEM * 256; u16* dst = (u16*)(ws + W_MEMKS);
    for (int i = gt; i < BS * NMEM * 256 / 8; i += nth) convert8(src + (size_t)i * 8, dst + (size_t)i * 8);
  }
  {
    const float* src = p.c_fv + (size_t)l * BS * PAST * 256; u16* dst = (u16*)(ws + W_FVTS);
    for (int i = gt; i < BS * (PAST / 8) * 256; i += nth) {
      const int c = i & 255, t8 = (i >> 8) & 255, b = i >> 16;
      float v[8];
#pragma unroll
      for (int j = 0; j < 8; ++j) v[j] = src[((size_t)(b * PAST + t8 * 8 + j)) * 256 + c];
      *(uint4*)(dst + ((size_t)(b * 256 + c) * TAS + t8 * 8)) = make_uint4(pk2(v[0], v[1]), pk2(v[2], v[3]), pk2(v[4], v[5]), pk2(v[6], v[7]));
    }
  }
  {
    const float* src = p.c_mv + (size_t)l * BS * NMEM * 256; u16* dst = (u16*)(ws + W_MEMVTS);
    for (int i = gt; i < BS * (NMEM / 8) * 256; i += nth) {
      const int c = i & 255, t8 = (i >> 8) & 31, b = i >> 13;
      float v[8];
#pragma unroll
      for (int j = 0; j < 8; ++j) v[j] = src[((size_t)(b * NMEM + t8 * 8 + j)) * 256 + c];
      *(uint4*)(dst + ((size_t)(b * 256 + c) * NMEM + t8 * 8)) = make_uint4(pk2(v[0], v[1]), pk2(v[2], v[3]), pk2(v[4], v[5]), pk2(v[6], v[7]));
    }
  }
}

template <bool AF32>
DI void gemm_gload(const void* __restrict__ Aptr, int lda, const u16* __restrict__ Bt, int ldb, int m0, int n0, int k0,
                   unsigned offA, unsigned offB, u32x4 (&ra)[4], u32x4 (&rb)[4], f32x4 (&rf)[8]) {
  constexpr int ES = AF32 ? 4 : 2;
  const char* ab = (const char*)Aptr + ((size_t)m0 * lda + k0) * ES;
  const char* bb = (const char*)Bt + ((size_t)n0 * ldb + k0) * 2;
#pragma unroll
  for (int i = 0; i < 4; ++i) {
    if constexpr (AF32) {
      const char* s = ab + (size_t)i * 64 * lda * 4 + offA;
      rf[2 * i] = *(const f32x4*)s; rf[2 * i + 1] = *(const f32x4*)(s + 16);
    } else {
      ra[i] = *(const u32x4*)(ab + (size_t)i * 64 * lda * 2 + offA);
    }
    rb[i] = *(const u32x4*)(bb + (size_t)i * 64 * ldb * 2 + offB);
  }
}
template <bool AF32, bool SSQ>
DI void gemm_mainloop(const void* __restrict__ Aptr, int lda, const u16* __restrict__ Bt, int ldb, int K, int m0, int n0,
                      char* smem, f32x16 (&acc)[4][2]) {
  u16* As = (u16*)smem; u16* Bs = As + 256 * LDT; float* rs_lds = (float*)(smem + 2 * GEMM_BUF * 2);
  const int t = tid(), lane = t & 63, w = t >> 6, g = lane >> 5, r = lane & 31;
  const int wm = w >> 2, wn = w & 3;
  const int lrow = t >> 3, lkc = t & 7;
  if constexpr (SSQ) {
    const int row = t >> 1, half = t & 1, kh = K >> 1;
    const u16* ap = (const u16*)Aptr + (size_t)(m0 + row) * lda + half * kh;
    float s = 0.f;
    for (int c = 0; c < kh; c += 8) {
      const u32x4 u = *(const u32x4*)(ap + c);
      s += bflo(u.x) * bflo(u.x) + bfhi(u.x) * bfhi(u.x) + bflo(u.y) * bflo(u.y) + bfhi(u.y) * bfhi(u.y);
      s += bflo(u.z) * bflo(u.z) + bfhi(u.z) * bfhi(u.z) + bflo(u.w) * bflo(u.w) + bfhi(u.w) * bfhi(u.w);
    }
    s += __shfl_xor(s, 1);
    if (half == 0) rs_lds[row] = rsqrtf(s / (float)K + EPS);
  }
  u32x4 ra[4], rb[4];
  f32x4 rf[8];
#pragma unroll
  for (int mi = 0; mi < 4; ++mi)
#pragma unroll
    for (int ni = 0; ni < 2; ++ni)
#pragma unroll
      for (int i = 0; i < 16; ++i) acc[mi][ni][i] = 0.f;

  const int KT = K >> 6;
  const unsigned offA = (unsigned)(lrow * lda + lkc * 8) * (AF32 ? 4u : 2u);
  const unsigned offB = (unsigned)(lrow * ldb + lkc * 8) * 2u;
  gemm_gload<AF32>(Aptr, lda, Bt, ldb, m0, n0, 0, offA, offB, ra, rb, rf);
  for (int kt = -1; kt < KT; ++kt) {
    if (kt + 1 < KT) {
      u16* Aw = As + ((kt + 1) & 1) * GEMM_BUF;
      u16* Bw = Bs + ((kt + 1) & 1) * GEMM_BUF;
#pragma unroll
      for (int i = 0; i < 4; ++i) {
        const int row = lrow + 64 * i;
        if constexpr (AF32) {
          const f32x4 a = rf[2 * i], b = rf[2 * i + 1];
          ra[i] = u32x4{pk2(a.x, a.y), pk2(a.z, a.w), pk2(b.x, b.y), pk2(b.z, b.w)};
        }
        *(u32x4*)(Aw + row * LDT + lkc * 8) = ra[i];
        *(u32x4*)(Bw + row * LDT + lkc * 8) = rb[i];
      }
      if (kt + 2 < KT) gemm_gload<AF32>(Aptr, lda, Bt, ldb, m0, n0, (kt + 2) << 6, offA, offB, ra, rb, rf);
    }
    __builtin_amdgcn_sched_barrier(0);
    if (kt >= 0) {
      const u16* Ar = As + (kt & 1) * GEMM_BUF;
      const u16* Br = Bs + (kt & 1) * GEMM_BUF;
#pragma unroll
      for (int ks = 0; ks < 4; ++ks) {
        bf16x8 wf[2], xf[4];
#pragma unroll
        for (int ni = 0; ni < 2; ++ni) wf[ni] = *(const bf16x8*)(Br + (wn * 64 + ni * 32 + r) * LDT + ks * 16 + g * 8);
#pragma unroll
        for (int mi = 0; mi < 4; ++mi) xf[mi] = *(const bf16x8*)(Ar + (wm * 128 + mi * 32 + r) * LDT + ks * 16 + g * 8);
#pragma unroll
        for (int mi = 0; mi < 4; ++mi)
#pragma unroll
          for (int ni = 0; ni < 2; ++ni) acc[mi][ni] = MFMA(wf[ni], xf[mi], acc[mi][ni]);
      }
    }
    __syncthreads();
  }
}

enum { EPI_H = 0, EPI_MEMKV = 1, EPI_Q = 2, EPI_KV = 3, EPI_KVC = 4, EPI_OUT = 5 };

template <int EPI>
DI void gemm_epilogue(const Params& p, int l, f32x16 (&acc)[4][2], int m0, int n0, char* smem, int mrows) {
  const float* rs_lds = (const float*)(smem + 2 * GEMM_BUF * 2);
  const int t = tid(), lane = t & 63, w = t >> 6, g = lane >> 5, r = lane & 31;
  const int wm = w >> 2, wn = w & 3;
  const int nw = n0 + wn * 64;
  char* ws = p.ws; float* out = p.out;
  const float2* tab = (const float2*)(ws + W_TAB);
#pragma unroll
  for (int mi = 0; mi < 4; ++mi) {
    const int lr = wm * 128 + mi * 32 + r;
    const int row = m0 + lr;
    if (row >= mrows) continue;
    if constexpr (EPI == EPI_H) {
      const bool is_s = row >= MP;
      const int b = is_s ? ((row - MP) >> 4) : (row >> 12);
      const int tt = is_s ? ((row - MP) & 15) : (row & 4095);
      if (nw < SEG_CKV) {
        u16* d = (u16*)(ws + W_CQ) + (size_t)row * 384;
#pragma unroll
        for (int ni = 0; ni < 2; ++ni)
#pragma unroll
          for (int j = 0; j < 4; ++j) { const int n = nw + ni * 32 + 8 * j + 4 * g; st4bf(d + n, acc[mi][ni][4 * j], acc[mi][ni][4 * j + 1], acc[mi][ni][4 * j + 2], acc[mi][ni][4 * j + 3]); }
      } else if (nw < SEG_KR) {
        u16* d = (u16*)(ws + W_CKV) + (size_t)row * 256;
        float* lo = is_s ? out + O_SLAT + (size_t)l * MS * 256 + (size_t)(row - MP) * 256 : out + O_PLAT + (size_t)l * MP * 256 + (size_t)row * 256;
#pragma unroll
        for (int ni = 0; ni < 2; ++ni)
#pragma unroll
          for (int j = 0; j < 4; ++j) {
            const int c = nw - SEG_CKV + ni * 32 + 8 * j + 4 * g;
            st4bf(d + c, acc[mi][ni][4 * j], acc[mi][ni][4 * j + 1], acc[mi][ni][4 * j + 2], acc[mi][ni][4 * j + 3]);
            *(float4*)(lo + c) = make_float4(acc[mi][ni][4 * j], acc[mi][ni][4 * j + 1], acc[mi][ni][4 * j + 2], acc[mi][ni][4 * j + 3]);
          }
      } else if (nw == SEG_KR) {
        const int pos = is_s ? PAST + tt : tt;
        float* ko = is_s ? out + O_SKR + (size_t)l * MS * 64 + (size_t)(row - MP) * 64 : out + O_PKR + (size_t)l * MP * 64 + (size_t)row * 64;
        u16* kb = is_s ? (u16*)(ws + W_KRBS) + (size_t)(b * TAS + PAST + tt) * 64 : (u16*)(ws + W_KRBP) + (size_t)row * 64;
#pragma unroll
        for (int j = 0; j < 4; ++j) {
          const int c = 8 * j + 4 * g;
          float y1[4], y2[4];
#pragma unroll
          for (int i = 0; i < 4; ++i) {
            const float2 cs = tab[pos * 32 + c + i];
            const float x1 = acc[mi][0][4 * j + i], x2 = acc[mi][1][4 * j + i];
            y1[i] = x1 * cs.x - x2 * cs.y; y2[i] = x1 * cs.y + x2 * cs.x;
          }
          *(float4*)(ko + c) = make_float4(y1[0], y1[1], y1[2], y1[3]);
          *(float4*)(ko + 32 + c) = make_float4(y2[0], y2[1], y2[2], y2[3]);
          st4bf(kb + c, y1[0], y1[1], y1[2], y1[3]);
          st4bf(kb + 32 + c, y2[0], y2[1], y2[2], y2[3]);
          __builtin_amdgcn_sched_barrier(0);
        }
      } else if (nw < SEG_FQ || (nw >= SEG_GFOX && nw < SEG_MQ) || (nw >= SEG_GMEM && nw < SEG_FL)) {
        const int gc0 = nw < SEG_FQ ? nw - SEG_GMLA : (nw < SEG_MQ ? 512 + nw - SEG_GFOX : 768 + nw - SEG_GMEM);
        u16* d = (u16*)(ws + W_GATE) + (size_t)row * GLD + gc0;
#pragma unroll
        for (int ni = 0; ni < 2; ++ni)
#pragma unroll
          for (int j = 0; j < 4; ++j) {
            const int c = ni * 32 + 8 * j + 4 * g;
            st4bf(d + c, silu(acc[mi][ni][4 * j]), silu(acc[mi][ni][4 * j + 1]), silu(acc[mi][ni][4 * j + 2]), silu(acc[mi][ni][4 * j + 3]));
          }
      } else if (nw < SEG_FK) {
        u16* d = (u16*)(ws + W_FQ) + (size_t)row * 256 + (nw - SEG_FQ);
#pragma unroll
        for (int ni = 0; ni < 2; ++ni)
#pragma unroll
          for (int j = 0; j < 4; ++j) { const int c = ni * 32 + 8 * j + 4 * g; st4bf(d + c, acc[mi][ni][4 * j], acc[mi][ni][4 * j + 1], acc[mi][ni][4 * j + 2], acc[mi][ni][4 * j + 3]); }
      } else if (nw < SEG_FV) {
        const int c0 = nw - SEG_FK;
        float* fo = (is_s ? out + O_SFK + (size_t)l * MS * 256 + (size_t)(row - MP) * 256 : out + O_PFK + (size_t)l * MP * 256 + (size_t)row * 256) + c0;
        u16* d = (is_s ? (u16*)(ws + W_FKBS) + (size_t)(b * TAS + PAST + tt) * 256 : (u16*)(ws + W_FKBP) + (size_t)row * 256) + c0;
#pragma unroll
        for (int ni = 0; ni < 2; ++ni)
#pragma unroll
          for (int j = 0; j < 4; ++j) {
            const int c = ni * 32 + 8 * j + 4 * g;
            *(float4*)(fo + c) = make_float4(acc[mi][ni][4 * j], acc[mi][ni][4 * j + 1], acc[mi][ni][4 * j + 2], acc[mi][ni][4 * j + 3]);
            st4bf(d + c, acc[mi][ni][4 * j], acc[mi][ni][4 * j + 1], acc[mi][ni][4 * j + 2], acc[mi][ni][4 * j + 3]);
          }
      } else if (nw < SEG_GFOX) {
        const int c0 = nw - SEG_FV;
        float* fo = (is_s ? out + O_SFV + (size_t)l * MS * 256 + (size_t)(row - MP) * 256 : out + O_PFV + (size_t)l * MP * 256 + (size_t)row * 256) + c0;
        u16* d = is_s ? (u16*)(ws + W_FVTS) + (size_t)(b * 256 + c0) * TAS + PAST + tt : (u16*)(ws + W_FVTP) + (size_t)(b * 256 + c0) * 4096 + tt;
        const size_t ldt = is_s ? TAS : 4096;
#pragma unroll
        for (int ni = 0; ni < 2; ++ni)
#pragma unroll
          for (int j = 0; j < 4; ++j) {
            const int c = ni * 32 + 8 * j + 4 * g;
            *(float4*)(fo + c) = make_float4(acc[mi][ni][4 * j], acc[mi][ni][4 * j + 1], acc[mi][ni][4 * j + 2], acc[mi][ni][4 * j + 3]);
#pragma unroll
            for (int i = 0; i < 4; ++i) d[(size_t)(c + i) * ldt] = (u16)(pk2(acc[mi][ni][4 * j + i], 0.f) & 0xffffu);
          }
      } else if (nw < SEG_GMEM) {
        u16* d = (u16*)(ws + W_MQ) + (size_t)row * 256 + (nw - SEG_MQ);
#pragma unroll
        for (int ni = 0; ni < 2; ++ni)
#pragma unroll
          for (int j = 0; j < 4; ++j) { const int c = ni * 32 + 8 * j + 4 * g; st4bf(d + c, acc[mi][ni][4 * j], acc[mi][ni][4 * j + 1], acc[mi][ni][4 * j + 2], acc[mi][ni][4 * j + 3]); }
      } else {
        if (g == 0) {
          float lf[4];
#pragma unroll
          for (int i = 0; i < 4; ++i) {
            const float z = acc[mi][0][i] + p.b_f[l * 4 + i];
            lf[i] = fminf(z, 0.f) - log1pf(expf(-fabsf(z)));
          }
          float* fo = is_s ? out + O_SLOGF + (size_t)l * MS * 4 + (size_t)(row - MP) * 4 : out + O_PLOGF + (size_t)l * MP * 4 + (size_t)row * 4;
          *(float4*)fo = make_float4(lf[0], lf[1], lf[2], lf[3]);
        }
      }
    } else if constexpr (EPI == EPI_MEMKV) {
      const int b = row >> 8, m = row & 255;
#pragma unroll
      for (int ni = 0; ni < 2; ++ni)
#pragma unroll
        for (int j = 0; j < 4; ++j) {
          const int n = nw + ni * 32 + 8 * j + 4 * g;
          const float4 v = make_float4(acc[mi][ni][4 * j], acc[mi][ni][4 * j + 1], acc[mi][ni][4 * j + 2], acc[mi][ni][4 * j + 3]);
          if (nw < 256) {
            *(float4*)(out + O_PMK + (size_t)l * 1024 * 256 + (size_t)row * 256 + n) = v;
            st4bf((u16*)(ws + W_MEMKP) + (size_t)l * 1024 * 256 + (size_t)row * 256 + n, v.x, v.y, v.z, v.w);
          } else {
            const int c = n - 256;
            *(float4*)(out + O_PMV + (size_t)l * 1024 * 256 + (size_t)row * 256 + c) = v;
            u16* d = (u16*)(ws + W_MEMVTP) + (size_t)l * 1024 * 256 + (size_t)(b * 256 + c) * NMEM + m;
            d[0] = (u16)(pk2(v.x, 0.f) & 0xffffu); d[NMEM] = (u16)(pk2(v.y, 0.f) & 0xffffu);
            d[2 * NMEM] = (u16)(pk2(v.z, 0.f) & 0xffffu); d[3 * NMEM] = (u16)(pk2(v.w, 0.f) & 0xffffu);
          }
        }
    } else if constexpr (EPI == EPI_Q) {
      const float rs = rs_lds[lr];
      const bool is_s = row >= MP;
      const int tt = is_s ? ((row - MP) & 15) : (row & 4095);
      const int pos = is_s ? PAST + tt : tt;
      u16* d = (u16*)(ws + W_XB) + (size_t)row * 768 + nw;
      if ((nw % 192) == 128) {
#pragma unroll
        for (int j = 0; j < 4; ++j) {
          const int c = 8 * j + 4 * g;
          float y1[4], y2[4];
#pragma unroll
          for (int i = 0; i < 4; ++i) {
            const float2 cs = tab[pos * 32 + c + i];
            const float x1 = acc[mi][0][4 * j + i] * rs, x2 = acc[mi][1][4 * j + i] * rs;
            y1[i] = x1 * cs.x - x2 * cs.y; y2[i] = x1 * cs.y + x2 * cs.x;
          }
          st4bf(d + c, y1[0], y1[1], y1[2], y1[3]);
          st4bf(d + 32 + c, y2[0], y2[1], y2[2], y2[3]);
          __builtin_amdgcn_sched_barrier(0);
        }
      } else {
#pragma unroll
        for (int ni = 0; ni < 2; ++ni)
#pragma unroll
          for (int j = 0; j < 4; ++j) {
            const int c = ni * 32 + 8 * j + 4 * g;
            st4bf(d + c, acc[mi][ni][4 * j] * rs, acc[mi][ni][4 * j + 1] * rs, acc[mi][ni][4 * j + 2] * rs, acc[mi][ni][4 * j + 3] * rs);
          }
      }
    } else if constexpr (EPI == EPI_KV || EPI == EPI_KVC) {
      float rs = 1.f; int b, tt; bool is_s;
      if constexpr (EPI == EPI_KV) {
        rs = rs_lds[lr]; is_s = row >= MP;
        b = is_s ? ((row - MP) >> 4) : (row >> 12);
        tt = is_s ? PAST + ((row - MP) & 15) : (row & 4095);
      } else { is_s = true; b = row >> 11; tt = row & 2047; }
      const int head = nw >> 8, c0 = nw & 255;
      const size_t T = is_s ? TAS : 4096;
      u16* knb = (u16*)(ws + (is_s ? W_KNS : W_KNP)); u16* vtb = (u16*)(ws + (is_s ? W_VTS : W_VTP));
      if (c0 < 128) {
        u16* d = knb + ((size_t)(b * 4 + head) * T + tt) * 128 + c0;
#pragma unroll
        for (int ni = 0; ni < 2; ++ni)
#pragma unroll
          for (int j = 0; j < 4; ++j) {
            const int c = ni * 32 + 8 * j + 4 * g;
            st4bf(d + c, acc[mi][ni][4 * j] * rs, acc[mi][ni][4 * j + 1] * rs, acc[mi][ni][4 * j + 2] * rs, acc[mi][ni][4 * j + 3] * rs);
          }
      } else {
        u16* d = vtb + ((size_t)(b * 4 + head) * 128 + (c0 - 128)) * T + tt;
#pragma unroll
        for (int ni = 0; ni < 2; ++ni)
#pragma unroll
          for (int j = 0; j < 4; ++j) {
            const int c = ni * 32 + 8 * j + 4 * g;
#pragma unroll
            for (int i = 0; i < 4; ++i) d[(size_t)(c + i) * T] = (u16)(pk2(acc[mi][ni][4 * j + i] * rs, 0.f) & 0xffffu);
          }
      }
    } else if constexpr (EPI == EPI_OUT) {
      const float* res = (l == 0) ? (row < MP ? p.x_prompt + (size_t)row * 1024 : p.x_sample + (size_t)(row - MP) * 1024) : out + O_Y + (size_t)row * 1024;
      float* zo = out + O_Y + (size_t)row * 1024;
#pragma unroll
      for (int ni = 0; ni < 2; ++ni)
#pragma unroll
        for (int j = 0; j < 4; ++j) {
          const int n = nw + ni * 32 + 8 * j + 4 * g;
          const float4 x = *(const float4*)(res + n);
          *(float4*)(zo + n) = make_float4(ALPHA * x.x + acc[mi][ni][4 * j], ALPHA * x.y + acc[mi][ni][4 * j + 1],
                                           ALPHA * x.z + acc[mi][ni][4 * j + 2], ALPHA * x.w + acc[mi][ni][4 * j + 3]);
        }
    }
  }
}

template <bool AF32, bool SSQ, int EPI>
DI void gemm_tile(const Params& p, int l, const void* A, int lda, const u16* Bt, int ldb, int K, int m0, int n0, char* smem, int mrows) {
  f32x16 acc[4][2];
  gemm_mainloop<AF32, SSQ>(A, lda, Bt, ldb, K, m0, n0, smem, acc);
  gemm_epilogue<EPI>(p, l, acc, m0, n0, smem, mrows);
}

typedef __attribute__((ext_vector_type(4))) float g8f4;
constexpr int G8_HALF = 128, G8_BK = 64, G8_HT = G8_HALF * G8_BK;
DI int g8_lds_byte(int r, int c) {
  int st = (r >> 4) * 2 + (c >> 5), rr = r & 15, cc = c & 31, ob = rr * 64 + cc * 2;
  return st * 1024 + (ob ^ (((ob >> 9) & 1) << 5));
}
DI void g8_stage_rc(int b, int& R, int& C) {
  int st = b / 1024, sb = b % 1024, swz = sb ^ (((sb >> 9) & 1) << 5);
  R = (st >> 1) * 16 + swz / 64; C = (st & 1) * 32 + (swz % 64) / 2;
}
DI void gemm8_mainloop(const u16* __restrict__ W, int ldw, const u16* __restrict__ X, int ldx, int K,
                       int brow, int bcol, char* smem, g8f4 (&acc)[2][2][4][2]) {
  u16* shm = (u16*)smem;
  #define SA(b,h) (shm+((b)*2+(h))*G8_HT)
  #define SB(b,h) (shm+(4+(b)*2+(h))*G8_HT)
  #define STAGE(P,BASE,LD,br,kt) do{long _g=(long)(br)*(LD)+(long)(kt)*G8_BK; \
    for(int _i=0;_i<2;++_i){int _b=tx*16+_i*8192;int _r,_c;g8_stage_rc(_b,_r,_c); \
      __builtin_amdgcn_global_load_lds((const unsigned*)(BASE+_g+(long)_r*(LD)+_c), \
        (__attribute__((address_space(3))) unsigned*)((char*)(P)+_b),16,0,0);}}while(0)
  #define LDA(dst,b,h) for(int m=0;m<4;++m)for(int k=0;k<2;++k) \
    dst[m][k]=*reinterpret_cast<const bf16x8*>((char*)SA(b,h)+g8_lds_byte(wr*64+m*16+fr,k*32+fq*8))
  #define LDB(dst,b,h) for(int n=0;n<2;++n)for(int k=0;k<2;++k) \
    dst[n][k]=*reinterpret_cast<const bf16x8*>((char*)SB(b,h)+g8_lds_byte(wc*32+n*16+fr,k*32+fq*8))
  #define MMA(ai,bj,At,Bt) do{__builtin_amdgcn_s_setprio(1); \
    for(int m=0;m<4;++m)for(int n=0;n<2;++n)for(int k=0;k<2;++k) \
      acc[ai][bj][m][n]=__builtin_amdgcn_mfma_f32_16x16x32_bf16(At[m][k],Bt[n][k],acc[ai][bj][m][n],0,0,0); \
    __builtin_amdgcn_s_setprio(0);}while(0)
  #define WAIT_V(n) asm volatile("s_waitcnt vmcnt(" #n ")":::"memory")
  #define WAIT_L(n) asm volatile("s_waitcnt lgkmcnt(" #n ")":::"memory")
  #define BAR __builtin_amdgcn_s_barrier()
  #define SCHED __builtin_amdgcn_sched_barrier(0)
  const int tx = tid();
  const int wid = tx >> 6, lane = tx & 63, wr = wid >> 2, wc = wid & 3, fr = lane & 15, fq = lane >> 4;
#pragma unroll
  for (int a_ = 0; a_ < 2; ++a_)
#pragma unroll
    for (int b_ = 0; b_ < 2; ++b_)
#pragma unroll
      for (int m = 0; m < 4; ++m)
#pragma unroll
        for (int n = 0; n < 2; ++n) acc[a_][b_][m][n] = g8f4{0.f, 0.f, 0.f, 0.f};
  bf16x8 At[4][2], B0[2][2], B1[2][2];
  const int nt = K / G8_BK;
  const u16* A = W; const u16* Bt = X;
  STAGE(SB(0,0),Bt,ldx,bcol,0); STAGE(SA(0,0),A,ldw,brow,0);
  STAGE(SB(0,1),Bt,ldx,bcol+G8_HALF,0); STAGE(SA(0,1),A,ldw,brow+G8_HALF,0);
  if(wr==1)BAR;
  WAIT_V(4); BAR;
  STAGE(SB(1,0),Bt,ldx,bcol,1); STAGE(SA(1,0),A,ldw,brow,1); STAGE(SB(1,1),Bt,ldx,bcol+G8_HALF,1);
  WAIT_V(6); BAR;
  for(int t=0;t<nt-2;t+=2){
    LDB(B0,0,0); SCHED; LDA(At,0,0); STAGE(SA(1,1),A,ldw,brow+G8_HALF,t+1);
    WAIT_L(8); BAR; WAIT_L(0); MMA(0,0,At,B0); BAR; SCHED;
    LDB(B1,0,1); STAGE(SB(0,0),Bt,ldx,bcol,t+2);
    BAR; WAIT_L(0); MMA(0,1,At,B1); BAR;
    LDA(At,0,1); STAGE(SA(0,0),A,ldw,brow,t+2);
    BAR; WAIT_L(0); MMA(1,0,At,B0); BAR; SCHED;
    STAGE(SB(0,1),Bt,ldx,bcol+G8_HALF,t+2);
    WAIT_V(6); BAR; MMA(1,1,At,B1); BAR;
    LDB(B0,1,0); SCHED; LDA(At,1,0); STAGE(SA(0,1),A,ldw,brow+G8_HALF,t+2);
    WAIT_L(8); BAR; WAIT_L(0); MMA(0,0,At,B0); BAR; SCHED;
    LDB(B1,1,1); STAGE(SB(1,0),Bt,ldx,bcol,t+3);
    BAR; WAIT_L(0); MMA(0,1,At,B1); BAR;
    LDA(At,1,1); STAGE(SA(1,0),A,ldw,brow,t+3);
    BAR; WAIT_L(0); MMA(1,0,At,B0); BAR; SCHED;
    STAGE(SB(1,1),Bt,ldx,bcol+G8_HALF,t+3);
    WAIT_V(6); BAR; MMA(1,1,At,B1); BAR;
  }
  { LDB(B0,0,0); LDA(At,0,0); STAGE(SA(1,1),A,ldw,brow+G8_HALF,nt-1);
    BAR; WAIT_L(0); MMA(0,0,At,B0); BAR;
    LDB(B1,0,1); BAR; WAIT_L(0); MMA(0,1,At,B1); BAR;
    LDA(At,0,1); WAIT_V(4); BAR; WAIT_L(0); MMA(1,0,At,B0); MMA(1,1,At,B1); BAR; }
  { LDB(B0,1,0); LDA(At,1,0); WAIT_V(2); BAR; WAIT_L(0); MMA(0,0,At,B0); BAR;
    LDB(B1,1,1); WAIT_V(0); BAR; WAIT_L(0); MMA(0,1,At,B1); BAR;
    LDA(At,1,1); BAR; WAIT_L(0); MMA(1,0,At,B0); MMA(1,1,At,B1); BAR; }
  if(wr==0)BAR;
  #undef SA
  #undef SB
  #undef STAGE
  #undef LDA
  #undef LDB
  #undef MMA
  #undef WAIT_V
  #undef WAIT_L
  #undef BAR
  #undef SCHED
}
DI void gemm8_out_tile(const Params& p, int l, const u16* W, int ldw, const u16* X, int ldx, int K, int brow, int bcol, char* smem, int mrows) {
  g8f4 acc[2][2][4][2];
  gemm8_mainloop(W, ldw, X, ldx, K, brow, bcol, smem, acc);
  const int tx = tid();
  const int wid = tx >> 6, lane = tx & 63, wr = wid >> 2, wc = wid & 3, fr = lane & 15, fq = lane >> 4;
  float* out = p.out;
#pragma unroll
  for (int bj = 0; bj < 2; ++bj)
#pragma unroll
    for (int nn = 0; nn < 2; ++nn) {
      const int row = bcol + bj * G8_HALF + wc * 32 + nn * 16 + fr;
      if (row >= mrows) continue;
      const float* res = (l == 0) ? (row < MP ? p.x_prompt + (size_t)row * 1024 : p.x_sample + (size_t)(row - MP) * 1024) : out + O_Y + (size_t)row * 1024;
      float* zo = out + O_Y + (size_t)row * 1024;
#pragma unroll
      for (int ai = 0; ai < 2; ++ai)
#pragma unroll
        for (int m = 0; m < 4; ++m) {
          const int n = brow + ai * G8_HALF + wr * 64 + m * 16 + fq * 4;
          const float4 x = *(const float4*)(res + n);
          const g8f4 v = acc[ai][bj][m][nn];
          *(float4*)(zo + n) = make_float4(ALPHA * x.x + v[0], ALPHA * x.y + v[1], ALPHA * x.z + v[2], ALPHA * x.w + v[3]);
        }
    }
}
DI void gemm8_h_tile(const Params& p, int l, const u16* W, int ldw, const u16* X, int ldx, int K, int brow, int bcol, char* smem) {
  g8f4 acc[2][2][4][2];
  gemm8_mainloop(W, ldw, X, ldx, K, brow, bcol, smem, acc);
  const int tx = tid();
  const int wid = tx >> 6, lane = tx & 63, wr = wid >> 2, wc = wid & 3, fr = lane & 15, fq = lane >> 4;
  char* ws = p.ws; float* out = p.out;
  const float2* tab = (const float2*)(ws + W_TAB);
#pragma unroll
  for (int bj = 0; bj < 2; ++bj)
#pragma unroll
    for (int nn = 0; nn < 2; ++nn) {
      const int row = bcol + bj * G8_HALF + wc * 32 + nn * 16 + fr;
      if (row >= MT) continue;
      const bool is_s = row >= MP;
      const int b = is_s ? ((row - MP) >> 4) : (row >> 12);
      const int tt = is_s ? ((row - MP) & 15) : (row & 4095);
#pragma unroll
      for (int ai = 0; ai < 2; ++ai) {
        const int nw = brow + ai * G8_HALF + wr * 64;
        if (nw == SEG_KR) {
          const int pos = is_s ? PAST + tt : tt;
          float* ko = is_s ? out + O_SKR + (size_t)l * MS * 64 + (size_t)(row - MP) * 64 : out + O_PKR + (size_t)l * MP * 64 + (size_t)row * 64;
          u16* kb = is_s ? (u16*)(ws + W_KRBS) + (size_t)(b * TAS + PAST + tt) * 64 : (u16*)(ws + W_KRBP) + (size_t)row * 64;
#pragma unroll
          for (int m = 0; m < 2; ++m) {
            const int c = m * 16 + fq * 4;
            const g8f4 x1 = acc[ai][bj][m][nn], x2 = acc[ai][bj][m + 2][nn];
            float y1[4], y2[4];
#pragma unroll
            for (int i = 0; i < 4; ++i) { const float2 cs = tab[pos * 32 + c + i]; y1[i] = x1[i] * cs.x - x2[i] * cs.y; y2[i] = x1[i] * cs.y + x2[i] * cs.x; }
            *(float4*)(ko + c) = make_float4(y1[0], y1[1], y1[2], y1[3]);
            *(float4*)(ko + 32 + c) = make_float4(y2[0], y2[1], y2[2], y2[3]);
            st4bf(kb + c, y1[0], y1[1], y1[2], y1[3]);
            st4bf(kb + 32 + c, y2[0], y2[1], y2[2], y2[3]);
          }
        } else if (nw >= SEG_FL) {
          if (fq == 0) {
            const g8f4 z4 = acc[ai][bj][0][nn];
            float lf[4];
#pragma unroll
            for (int i = 0; i < 4; ++i) { const float z = z4[i] + p.b_f[l * 4 + i]; lf[i] = fminf(z, 0.f) - log1pf(expf(-fabsf(z))); }
            float* fo = is_s ? out + O_SLOGF + (size_t)l * MS * 4 + (size_t)(row - MP) * 4 : out + O_PLOGF + (size_t)l * MP * 4 + (size_t)row * 4;
            *(float4*)fo = make_float4(lf[0], lf[1], lf[2], lf[3]);
          }
        } else {
#pragma unroll
          for (int m = 0; m < 4; ++m) {
            const int c = m * 16 + fq * 4;
            const g8f4 v = acc[ai][bj][m][nn];
            if (nw < SEG_CKV) {
              st4bf((u16*)(ws + W_CQ) + (size_t)row * 384 + nw + c, v[0], v[1], v[2], v[3]);
            } else if (nw < SEG_KR) {
              const int cc = nw - SEG_CKV + c;
              st4bf((u16*)(ws + W_CKV) + (size_t)row * 256 + cc, v[0], v[1], v[2], v[3]);
              float* lo = is_s ? out + O_SLAT + (size_t)l * MS * 256 + (size_t)(row - MP) * 256 : out + O_PLAT + (size_t)l * MP * 256 + (size_t)row * 256;
              *(float4*)(lo + cc) = make_float4(v[0], v[1], v[2], v[3]);
            } else if (nw < SEG_FQ || (nw >= SEG_GFOX && nw < SEG_MQ) || (nw >= SEG_GMEM && nw < SEG_FL)) {
              const int gc0 = nw < SEG_FQ ? nw - SEG_GMLA : (nw < SEG_MQ ? 512 + nw - SEG_GFOX : 768 + nw - SEG_GMEM);
              st4bf((u16*)(ws + W_GATE) + (size_t)row * GLD + gc0 + c, silu(v[0]), silu(v[1]), silu(v[2]), silu(v[3]));
            } else if (nw < SEG_FK) {
              st4bf((u16*)(ws + W_FQ) + (size_t)row * 256 + (nw - SEG_FQ) + c, v[0], v[1], v[2], v[3]);
            } else if (nw < SEG_FV) {
              const int cc = nw - SEG_FK + c;
              float* fo = (is_s ? out + O_SFK + (size_t)l * MS * 256 + (size_t)(row - MP) * 256 : out + O_PFK + (size_t)l * MP * 256 + (size_t)row * 256) + cc;
              u16* d = (is_s ? (u16*)(ws + W_FKBS) + (size_t)(b * TAS + PAST + tt) * 256 : (u16*)(ws + W_FKBP) + (size_t)row * 256) + cc;
              *(float4*)fo = make_float4(v[0], v[1], v[2], v[3]);
              st4bf(d, v[0], v[1], v[2], v[3]);
            } else if (nw < SEG_GFOX) {
              const int cc = nw - SEG_FV + c;
              float* fo = (is_s ? out + O_SFV + (size_t)l * MS * 256 + (size_t)(row - MP) * 256 : out + O_PFV + (size_t)l * MP * 256 + (size_t)row * 256) + cc;
              *(float4*)fo = make_float4(v[0], v[1], v[2], v[3]);
              u16* d = is_s ? (u16*)(ws + W_FVTS) + (size_t)(b * 256 + cc) * TAS + PAST + tt : (u16*)(ws + W_FVTP) + (size_t)(b * 256 + cc) * 4096 + tt;
              const size_t ldt = is_s ? TAS : 4096;
#pragma unroll
              for (int i = 0; i < 4; ++i) st_quad_t(d + (size_t)i * ldt, v[i], (fr & 3) == 0);
            } else {
              st4bf((u16*)(ws + W_MQ) + (size_t)row * 256 + (nw - SEG_MQ) + c, v[0], v[1], v[2], v[3]);
            }
          }
        }
      }
    }
}

template <bool CACHE>
DI void gemm8_kv_tile(const Params& p, int l, const u16* W, const u16* X, int brow, int bcol, char* smem) {
  float* rs_lds = (float*)(smem + 2 * GEMM_BUF * 2);
  const int tx = tid();
  if constexpr (!CACHE) {
    const int row = tx >> 1, half = tx & 1;
    const u16* ap = X + (size_t)(bcol + row) * 256 + half * 128;
    float s = 0.f;
#pragma unroll
    for (int c = 0; c < 128; c += 8) {
      const u32x4 u = *(const u32x4*)(ap + c);
      s += bflo(u.x) * bflo(u.x) + bfhi(u.x) * bfhi(u.x) + bflo(u.y) * bflo(u.y) + bfhi(u.y) * bfhi(u.y);
      s += bflo(u.z) * bflo(u.z) + bfhi(u.z) * bfhi(u.z) + bflo(u.w) * bflo(u.w) + bfhi(u.w) * bfhi(u.w);
    }
    s += __shfl_xor(s, 1);
    if (half == 0) rs_lds[row] = rsqrtf(s * (1.f / 256.f) + EPS);
  }
  g8f4 acc[2][2][4][2];
  gemm8_mainloop(W, 256, X, 256, 256, brow, bcol, smem, acc);
  const int wid = tx >> 6, lane = tx & 63, wr = wid >> 2, wc = wid & 3, fr = lane & 15, fq = lane >> 4;
  char* ws = p.ws;
#pragma unroll
  for (int bj = 0; bj < 2; ++bj)
#pragma unroll
    for (int nn = 0; nn < 2; ++nn) {
      const int tl = bj * G8_HALF + wc * 32 + nn * 16 + fr;
      const int row = bcol + tl;
      float rs = 1.f; int b, tt; bool is_s;
      if constexpr (CACHE) { is_s = true; b = row >> 11; tt = row & 2047; }
      else {
        if (row >= MT) continue;
        rs = rs_lds[tl]; is_s = row >= MP;
        b = is_s ? ((row - MP) >> 4) : (row >> 12);
        tt = is_s ? PAST + ((row - MP) & 15) : (row & 4095);
      }
      const size_t T = is_s ? TAS : 4096;
      u16* knb = (u16*)(ws + (is_s ? W_KNS : W_KNP)); u16* vtb = (u16*)(ws + (is_s ? W_VTS : W_VTP));
#pragma unroll
      for (int ai = 0; ai < 2; ++ai) {
        const int nw = brow + ai * G8_HALF + wr * 64;
        const int head = nw >> 8, c0 = nw & 255;
        if (c0 < 128) {
          u16* d = knb + ((size_t)(b * 4 + head) * T + tt) * 128 + c0;
#pragma unroll
          for (int m = 0; m < 4; ++m) { const g8f4 v = acc[ai][bj][m][nn]; st4bf(d + m * 16 + fq * 4, v[0] * rs, v[1] * rs, v[2] * rs, v[3] * rs); }
        } else {
          u16* d = vtb + ((size_t)(b * 4 + head) * 128 + (c0 - 128)) * T + tt;
#pragma unroll
          for (int m = 0; m < 4; ++m) {
            const g8f4 v = acc[ai][bj][m][nn];
#pragma unroll
            for (int i = 0; i < 4; ++i) st_quad_t(d + (size_t)(m * 16 + fq * 4 + i) * T, v[i] * rs, (fr & 3) == 0);
          }
        }
      }
    }
}

struct AttnItem {
  const u16* q; const u16* k1; const u16* k2; const u16* vt; const float* cum; u16* gate;
  int ldq, ldk1, ldv, qrow0, nq, qpos0, Tk, ntiles, dry;
};

template <int DK>
DI void attn_loadK(const AttnItem& a, int k0, unsigned offK, u32x4 (&rk)[3]) {
  if constexpr (DK == 192) {
    const char* b1 = (const char*)(a.k1 + (size_t)k0 * 128);
    const char* b2 = (const char*)(a.k2 + (size_t)k0 * 64);
#pragma unroll
    for (int i = 0; i < 2; ++i) rk[i] = *(const u32x4*)(b1 + (size_t)i * 8192 + offK);
    rk[2] = *(const u32x4*)(b2 + offK);
  } else {
    const char* b1 = (const char*)(a.k1 + (size_t)k0 * a.ldk1);
    rk[0] = *(const u32x4*)(b1 + offK);
  }
}
template <int DK>
DI void attn_storeK(u16* Ks, int t, u32x4 (&rk)[3]) {
  constexpr int KS = DK + 8;
  if constexpr (DK == 192) {
#pragma unroll
    for (int i = 0; i < 2; ++i) { const int c = t + 512 * i; const int key = c >> 4, kc = c & 15; *(u32x4*)(Ks + key * KS + kc * 8) = rk[i]; }
    { const int key = t >> 3, kc = t & 7; *(u32x4*)(Ks + key * KS + 128 + kc * 8) = rk[2]; }
  } else {
    const int key = t >> 3, kc = t & 7; *(u32x4*)(Ks + key * KS + kc * 8) = rk[0];
  }
}
template <int DV, int MODE>
DI void attn_loadV(const AttnItem& a, int k0, int t, unsigned offV, u32x4 (&rv)[2], float& rc) {
  const char* bv = (const char*)(a.vt + k0);
#pragma unroll
  for (int i = 0; i < DV / 64; ++i) rv[i] = *(const u32x4*)(bv + (size_t)i * 128 * a.ldv + offV);
  if constexpr (MODE == 1) { if (t < 64) rc = a.cum[k0 + t]; }
}
template <int DV, int MODE>
DI void attn_storeV(u16* Vs, float* Cs, int t, u32x4 (&rv)[2], float rc) {
  constexpr int VS = 68;
#pragma unroll
  for (int i = 0; i < DV / 64; ++i) {
    const int c = t + 512 * i; const int d = c >> 3, kc = c & 7;
    *(uint2*)(Vs + d * VS + kc * 8) = make_uint2(rv[i].x, rv[i].y);
    *(uint2*)(Vs + d * VS + kc * 8 + 4) = make_uint2(rv[i].z, rv[i].w);
  }
  if constexpr (MODE == 1) { if (t < 64) Cs[t] = rc * LOG2E; }
}

template <int DK, int DV, int MODE>
DI void attn_item(const AttnItem& a, float sc, char* smem) {
  constexpr int KS = DK + 8;
  constexpr int VS = 68;
  constexpr int STG = 64 * KS * 2 + DV * VS * 2 + 256;
  const int t = tid(), lane = t & 63, w = t >> 6, g = lane >> 5, r = lane & 31;
  const bool wave_active = (w * 32) < a.nq;
  const int ql = w * 32 + r;
  const int qlc = ql < a.nq ? ql : a.nq - 1;
  const int qrow = a.qrow0 + qlc;
  const int qpos = a.qpos0 + qlc;
  const int wq_lo = a.qpos0 + w * 32;
  const int wq_hi = a.qpos0 + ((w * 32 + 31) < a.nq ? (w * 32 + 31) : a.nq - 1);

  bf16x8 qf[DK / 16];
#pragma unroll
  for (int ks = 0; ks < DK / 16; ++ks) qf[ks] = *(const bf16x8*)(a.q + (size_t)qrow * a.ldq + ks * 16 + g * 8);
  f32x16 o[DV / 32];
#pragma unroll
  for (int db = 0; db < DV / 32; ++db)
#pragma unroll
    for (int i = 0; i < 16; ++i) o[db][i] = 0.f;
  float mrun = -1e30f, lsum = 0.f;
  float cq2 = 0.f;
  if constexpr (MODE == 1) cq2 = a.cum[qpos] * LOG2E;

  u32x4 rk[3], rv[2];
  float rc = 0.f;
  const unsigned offK = DK == 192 ? (unsigned)t * 16u : (unsigned)((t >> 3) * a.ldk1 * 2 + (t & 7) * 16);
  const unsigned offV = (unsigned)((t >> 3) * a.ldv * 2 + (t & 7) * 16);
  attn_loadK<DK>(a, 0, offK, rk);
  attn_loadV<DV, MODE>(a, 0, t, offV, rv, rc);
  for (int kt = -1; kt < a.ntiles; ++kt) {
    const int k0 = kt * 64;
    if (kt + 1 < a.ntiles) {
      char* sw = smem + ((kt + 1) & 1) * STG;
      attn_storeK<DK>((u16*)sw, t, rk);
      attn_storeV<DV, MODE>((u16*)(sw + 64 * KS * 2), (float*)(sw + 64 * KS * 2 + DV * VS * 2), t, rv, rc);
      if (kt + 2 < a.ntiles) { attn_loadK<DK>(a, k0 + 128, offK, rk); attn_loadV<DV, MODE>(a, k0 + 128, t, offV, rv, rc); }
    }
    __builtin_amdgcn_sched_barrier(0);
    const char* sr = smem + (kt & 1) * STG;
    const u16* Ks = (const u16*)sr; const u16* Vs = (const u16*)(sr + 64 * KS * 2); const float* Cs = (const float*)(sr + 64 * KS * 2 + DV * VS * 2);
    bool do_tile = wave_active && kt >= 0;
    if constexpr (MODE == 0) do_tile = do_tile && (kt <= (wq_lo >> 6));
    if constexpr (MODE == 1) do_tile = do_tile && (k0 <= wq_hi);
    f32x16 s[2];
    if (do_tile) {
#pragma unroll
      for (int kb = 0; kb < 2; ++kb) {
#pragma unroll
        for (int i = 0; i < 16; ++i) s[kb][i] = 0.f;
#pragma unroll
        for (int ks = 0; ks < DK / 16; ++ks) {
          const bf16x8 kf = *(const bf16x8*)(Ks + (kb * 32 + r) * KS + ks * 16 + g * 8);
          s[kb] = MFMA(kf, qf[ks], s[kb]);
          if ((ks & 3) == 3) __builtin_amdgcn_sched_barrier(0);
        }
      }
    }
    if (do_tile) {
      bool need_mask = false;
      if constexpr (MODE == 0) need_mask = (k0 + 64 > a.Tk);
      if constexpr (MODE == 1) need_mask = (k0 + 63 > wq_lo);
      float tmax = -1e30f;
      if constexpr (MODE == 1) {
#pragma unroll
        for (int kb = 0; kb < 2; ++kb)
#pragma unroll
          for (int j = 0; j < 4; ++j) {
            const float4 cb = *(const float4*)(Cs + kb * 32 + 8 * j + 4 * g);
            s[kb][4 * j + 0] = fmaf(s[kb][4 * j + 0], sc, cq2 - cb.x);
            s[kb][4 * j + 1] = fmaf(s[kb][4 * j + 1], sc, cq2 - cb.y);
            s[kb][4 * j + 2] = fmaf(s[kb][4 * j + 2], sc, cq2 - cb.z);
            s[kb][4 * j + 3] = fmaf(s[kb][4 * j + 3], sc, cq2 - cb.w);
          }
      }
      if (need_mask) {
#pragma unroll
        for (int kb = 0; kb < 2; ++kb)
#pragma unroll
          for (int j = 0; j < 4; ++j)
#pragma unroll
            for (int i = 0; i < 4; ++i) {
              const int key = k0 + kb * 32 + 8 * j + 4 * g + i;
              bool ok = true;
              if constexpr (MODE == 0) ok = key < a.Tk;
              if constexpr (MODE == 1) ok = key <= qpos;
              s[kb][4 * j + i] = ok ? s[kb][4 * j + i] : -1e30f;
            }
      }
#pragma unroll
      for (int kb = 0; kb < 2; ++kb)
#pragma unroll
        for (int i = 0; i < 16; ++i) tmax = fmaxf(tmax, s[kb][i]);
      if constexpr (MODE != 1) tmax *= sc;
      tmax = half_max(tmax);
      const float mnew = fmaxf(mrun, tmax);
      const float alpha = ex2(mrun - mnew);
      const bool changed = mnew != mrun;
      mrun = mnew;
      typedef float f32x2 __attribute__((ext_vector_type(2)));
      f32x2 ps2 = {0.f, 0.f};
      const f32x2 sc2 = {sc, sc}, nm2 = {-mnew, -mnew};
#pragma unroll
      for (int kb = 0; kb < 2; ++kb)
#pragma unroll
        for (int i = 0; i < 16; i += 2) {
          f32x2 a2 = {s[kb][i], s[kb][i + 1]};
          if constexpr (MODE == 1) a2 = a2 + nm2; else a2 = __builtin_elementwise_fma(a2, sc2, nm2);
          f32x2 p2 = {ex2(a2.x), ex2(a2.y)};
          s[kb][i] = p2.x; s[kb][i + 1] = p2.y;
          ps2 = ps2 + p2;
        }
      const float psum = ps2.x + ps2.y;
      lsum = lsum * alpha + psum;
      if (__builtin_amdgcn_ballot_w64(changed) != 0ull) {
#pragma unroll
        for (int db = 0; db < DV / 32; ++db)
#pragma unroll
          for (int i = 0; i < 16; ++i) o[db][i] *= alpha;
      }
#pragma unroll
      for (int kb = 0; kb < 2; ++kb)
#pragma unroll
        for (int u = 0; u < 2; ++u) {
          const unsigned p0 = pk2(s[kb][8 * u + 0], s[kb][8 * u + 1]), p1 = pk2(s[kb][8 * u + 2], s[kb][8 * u + 3]);
          const unsigned p2 = pk2(s[kb][8 * u + 4], s[kb][8 * u + 5]), p3 = pk2(s[kb][8 * u + 6], s[kb][8 * u + 7]);
          const bf16x8 pf = __builtin_bit_cast(bf16x8, make_uint4(p0, p1, p2, p3));
#pragma unroll
          for (int db = 0; db < DV / 32; ++db) {
            const u16* vp = Vs + (db * 32 + r) * VS + kb * 32 + 16 * u + 4 * g;
            const s16x4 lo = *(const s16x4*)vp;
            const s16x4 hi = *(const s16x4*)(vp + 8);
            const bf16x8 vf = __builtin_shufflevector(lo, hi, 0, 1, 2, 3, 4, 5, 6, 7);
            o[db] = MFMA(vf, pf, o[db]);
          }
          __builtin_amdgcn_sched_barrier(0);
        }
    }
    __syncthreads();
  }
  if (wave_active) {
    const float ltot = half_sum(lsum);
    const float inv = 1.f / ltot;
    if (ql < a.nq && !a.dry) {
      u16* gp = a.gate + (size_t)qrow * GLD;
#pragma unroll
      for (int db = 0; db < DV / 32; ++db)
#pragma unroll
        for (int j = 0; j < 4; ++j) {
          const int d = db * 32 + 8 * j + 4 * g;
          const uint2 gv = *(const uint2*)(gp + d);
          st4bf(gp + d, o[db][4 * j] * inv * bflo(gv.x), o[db][4 * j + 1] * inv * bfhi(gv.x),
                o[db][4 * j + 2] * inv * bflo(gv.y), o[db][4 * j + 3] * inv * bfhi(gv.y));
        }
    }
  }
}

DI float wave_sum(float v) {
#pragma unroll
  for (int o = 32; o > 0; o >>= 1) v += __shfl_xor(v, o);
  return v;
}
DI void lat_rows(const Params& p, int l, int row0, int nrows) {
  const int t_ = tid(); const int lane = t_ & 63, w = t_ >> 6;
  const f32x4 gv = *(const f32x4*)(p.kvn_g + l * 256 + lane * 4);
  f32x4 v[8];
#pragma unroll
  for (int k = 0; k < 8; ++k) {
    const int row = row0 + w + 8 * k;
    const float* d = row < MP ? p.out + O_PLAT + (size_t)l * MP * 256 + (size_t)row * 256 : p.out + O_SLAT + (size_t)l * MS * 256 + (size_t)(row - MP) * 256;
    v[k] = *(const f32x4*)(d + lane * 4);
  }
#pragma unroll
  for (int k = 0; k < 8; ++k) {
    const int row = row0 + w + 8 * k;
    float* d = row < MP ? p.out + O_PLAT + (size_t)l * MP * 256 + (size_t)row * 256 : p.out + O_SLAT + (size_t)l * MS * 256 + (size_t)(row - MP) * 256;
    const float ss = wave_sum(v[k].x * v[k].x + v[k].y * v[k].y + v[k].z * v[k].z + v[k].w * v[k].w);
    const float rs = rsqrtf(ss * (1.f / 256.f) + EPS);
    *(f32x4*)(d + lane * 4) = v[k] * rs * gv;
  }
}
DI void ln_rows(const Params& p, int l, int row0, int nrows) {
  const int t_ = tid(); const int lane = t_ & 63, w = t_ >> 6;
  u16* Xb = (u16*)(p.ws + W_XB);
  f32x4 v[4][4], gg[4], bb[4];
#pragma unroll
  for (int k = 0; k < 4; ++k)
#pragma unroll
    for (int i = 0; i < 4; ++i) v[k][i] = *(const f32x4*)(p.out + O_Y + (size_t)(row0 + w + 8 * k) * 1024 + i * 256 + lane * 4);
#pragma unroll
  for (int i = 0; i < 4; ++i) { gg[i] = *(const f32x4*)(p.ln_g + l * 1024 + i * 256 + lane * 4); bb[i] = *(const f32x4*)(p.ln_b + l * 1024 + i * 256 + lane * 4); }
#pragma unroll
  for (int k = 0; k < 4; ++k) {
    const int row = row0 + w + 8 * k;
    float* d = p.out + O_Y + (size_t)row * 1024;
    float s = 0.f;
#pragma unroll
    for (int i = 0; i < 4; ++i) s += v[k][i].x + v[k][i].y + v[k][i].z + v[k][i].w;
    const float mu = wave_sum(s) * (1.f / 1024.f);
    float q = 0.f;
#pragma unroll
    for (int i = 0; i < 4; ++i) { v[k][i] = v[k][i] - mu; q += v[k][i].x * v[k][i].x + v[k][i].y * v[k][i].y + v[k][i].z * v[k][i].z + v[k][i].w * v[k][i].w; }
    const float rstd = rsqrtf(wave_sum(q) * (1.f / 1024.f) + EPS);
#pragma unroll
    for (int i = 0; i < 4; ++i) {
      const f32x4 y = v[k][i] * rstd * gg[i] + bb[i];
      *(f32x4*)(d + i * 256 + lane * 4) = y;
      if (l == 0) st4bf(Xb + (size_t)row * 1024 + i * 256 + lane * 4, y.x, y.y, y.z, y.w);
    }
  }
}
DI void cumsum_item(const Params& p, int l, int idx, char* smem) {
  float* sw = (float*)smem;
  const int t = tid(), lane = t & 63, w = t >> 6;
  const bool samp = idx >= 16;
  const int bh = samp ? idx - 16 : idx, b = bh >> 2, h = bh & 3;
  const int t0 = t * 8;
  float v[8];
#pragma unroll
  for (int j = 0; j < 8; ++j) {
    const int tt = t0 + j;
    float x = 0.f;
    if (!samp) x = p.out[O_PLOGF + (size_t)l * MP * 4 + (size_t)(b * 4096 + tt) * 4 + h];
    else if (tt < PAST) x = p.c_logf[(size_t)l * BS * PAST * 4 + (size_t)(b * PAST + tt) * 4 + h];
    else if (tt < TKS) x = p.out[O_SLOGF + (size_t)l * MS * 4 + (size_t)(b * 16 + tt - PAST) * 4 + h];
    v[j] = x;
  }
#pragma unroll
  for (int j = 1; j < 8; ++j) v[j] += v[j - 1];
  float tot = v[7], inc = tot;
#pragma unroll
  for (int o = 1; o < 64; o <<= 1) { const float n = __shfl_up(inc, o); if (lane >= o) inc += n; }
  if (lane == 63) sw[w] = inc;
  __syncthreads();
  float base = inc - tot;
  for (int i = 0; i < w; ++i) base += sw[i];
  float* dst = samp ? (float*)(p.ws + W_CUMS) + (size_t)bh * TAS : (float*)(p.ws + W_CUMP) + (size_t)bh * 4096;
  const int tmax = samp ? TAS : 4096;
  if (t0 < tmax) {
#pragma unroll
    for (int j = 0; j < 8; j += 4) *(float4*)(dst + t0 + j) = make_float4(base + v[j], base + v[j + 1], base + v[j + 2], base + v[j + 3]);
  }
}

DI void phase_p1(const Params& p, int l, unsigned* ctr, int* s_item, char* smem) {
  phase_cacheconv(p, l);
  const int NT = N1 / 256;
  const u16* Xb = (const u16*)(p.ws + W_XB);
  const u16* Wt = (const u16*)(p.ws + W_WIN) + (size_t)l * N1 * 1024;
  const int n_mem = (l == 0) ? 2 : 0;
  FOR_QUEUES(q, j, q_mtiles(q, 65) * NT + n_mem)
    const int kq = q_mtiles(q, 65), n_h = kq * NT;
    if (j < n_h) {
      const int nt = j / kq, ml = j - nt * kq;
      const int mt = q + 8 * ml;
      gemm8_h_tile(p, l, Wt, 1024, Xb, 1024, 1024, nt * 256, mt * 256, smem);
    } else {
      const int jj = q * 2 + (j - n_h), l2 = jj >> 3, mt = (jj >> 1) & 3, nt = jj & 1;
      gemm_tile<false, false, EPI_MEMKV>(p, l2, p.ws + W_MEMB, 1024, (const u16*)(p.ws + W_WMKV) + (size_t)l2 * 512 * 1024, 1024, 1024, mt * 256, nt * 256, smem, 1024);
    }
  END_QUEUES
}
DI void phase_p3(const Params& p, int l, unsigned* ctr, int* s_item, char* smem, bool skip_lat = false) {
  FOR_QUEUES(q, j, 6 + 8 * 4 + q_mtiles(q, 65) * 7 + (258 - q + 7) / 8)
    const int kq = q_mtiles(q, 65);
    const int e0 = 6, e1 = e0 + 8 * 4, e2 = e1 + kq * 4, e3 = e2 + kq * 3;
    if (j < e0) cumsum_item(p, l, q * 6 + j, smem);
    else if (j < e1) {
      const int jj = j - e0, mt = q + 8 * (jj >> 2), nt = jj & 3;
      gemm8_kv_tile<true>(p, l, (const u16*)(p.ws + W_WUKV) + (size_t)l * 1024 * 256, (const u16*)(p.ws + W_LATC), nt * 256, mt * 256, smem);
    } else if (j < e2) {
      const int jj = j - e1, mt = q + 8 * (jj >> 2), nt = jj & 3;
      gemm8_kv_tile<false>(p, l, (const u16*)(p.ws + W_WUKVF) + (size_t)l * 1024 * 256, (const u16*)(p.ws + W_CKV), nt * 256, mt * 256, smem);
    } else if (j < e3) {
      const int jj = j - e2, mt = q + 8 * (jj / 3), nt = jj % 3;
      gemm_tile<false, true, EPI_Q>(p, l, p.ws + W_CQ, 384, (const u16*)(p.ws + W_WUQ) + (size_t)l * 768 * 384, 384, 384, mt * 256, nt * 256, smem, MT);
    } else if (!skip_lat) lat_rows(p, l, (q + 8 * (j - e3)) * 64, 64);
  END_QUEUES
}
DI void phase_p4(const Params& p, int l, unsigned* ctr, int* s_item, char* smem, int dry = 0) {
  char* ws = p.ws;
  const float sc_mla = 0.07216878364870322f * LOG2E, sc_64 = 0.125f * LOG2E;
  unsigned* barw = (unsigned*)(p.ws + W_BAR);
  FOR_QUEUES(q, j, 108 + ((q < 4 && !dry) ? 1 : 0))
    if (j >= 108) {
      if (threadIdx.x == 0) {
        XB_SPIN(xb_ld(barw + XB_SCNT(l)) < 96u, barw);
        __builtin_amdgcn_fence(__ATOMIC_ACQUIRE, "agent");
        asm volatile("s_waitcnt vmcnt(0)" ::: "memory");
      }
      __syncthreads();
      gemm8_out_tile(p, l, (const u16*)(ws + W_WOUT) + (size_t)l * 1024 * GLD, GLD, (const u16*)(ws + W_GATE), GLD, 1024, q * 256, 64 * 256, smem, MT);
    } else {
    int it, b, h, qb = 0;
    if (j < 12) { it = j < 4 ? 0 : (j < 8 ? 32 : 1600); b = q; h = j & 3; }
    else if (j < 76) { const int jj = j - 12; it = jj < 32 ? 64 : 576; const int k = jj & 31; qb = 15 - (k >> 1); const int bh = q + 8 * (k & 1); b = bh >> 2; h = bh & 3; }
    else { const int k = j - 76; it = 1088; qb = k >> 1; const int bh = q + 8 * (k & 1); b = bh >> 2; h = bh & 3; }
    AttnItem a;
    a.k2 = nullptr; a.cum = nullptr; a.dry = dry;
    if (it < 32 || (it >= 64 && it < 576)) {
      const bool samp = it < 32;
      const int T = samp ? TAS : 4096;
      a.q = (const u16*)(ws + W_XB) + h * 192; a.ldq = 768;
      a.k1 = (const u16*)(ws + (samp ? W_KNS : W_KNP)) + (size_t)(b * 4 + h) * T * 128; a.ldk1 = 128;
      a.k2 = (const u16*)(ws + (samp ? W_KRBS : W_KRBP)) + (size_t)b * T * 64;
      a.vt = (const u16*)(ws + (samp ? W_VTS : W_VTP)) + (size_t)(b * 4 + h) * 128 * T; a.ldv = T;
      a.gate = (u16*)(ws + W_GATE) + h * 128;
      if (samp) { a.qrow0 = MP + b * 16; a.nq = 16; a.qpos0 = PAST; a.Tk = TKS; a.ntiles = 33; }
      else { a.qrow0 = b * 4096 + qb * 256; a.nq = 256; a.qpos0 = qb * 256; a.Tk = 4096; a.ntiles = 4 * qb + 4; }
      attn_item<192, 128, 0>(a, sc_mla, smem);
    } else if (it < 64 || it < 1088) {
      const bool samp = it < 64;
      const int T = samp ? TAS : 4096;
      a.q = (const u16*)(ws + W_FQ) + h * 64; a.ldq = 256;
      a.k1 = (const u16*)(ws + (samp ? W_FKBS : W_FKBP)) + (size_t)b * T * 256 + h * 64; a.ldk1 = 256;
      a.vt = (const u16*)(ws + (samp ? W_FVTS : W_FVTP)) + (size_t)(b * 4 + h) * 64 * T; a.ldv = T;
      a.cum = (const float*)(ws + (samp ? W_CUMS : W_CUMP)) + (size_t)(b * 4 + h) * T;
      a.gate = (u16*)(ws + W_GATE) + 512 + h * 64;
      if (samp) { a.qrow0 = MP + b * 16; a.nq = 16; a.qpos0 = PAST; a.Tk = TKS; a.ntiles = 33; }
      else { a.qrow0 = b * 4096 + qb * 256; a.nq = 256; a.qpos0 = qb * 256; a.Tk = 4096; a.ntiles = 4 * qb + 4; }
      attn_item<64, 64, 1>(a, sc_64, smem);
    } else {
      const bool samp = it >= 1600;
      a.q = (const u16*)(ws + W_MQ) + h * 64; a.ldq = 256;
      a.k1 = (samp ? (const u16*)(ws + W_MEMKS) : (const u16*)(ws + W_MEMKP) + (size_t)l * 1024 * 256) + (size_t)b * NMEM * 256 + h * 64; a.ldk1 = 256;
      a.vt = (samp ? (const u16*)(ws + W_MEMVTS) : (const u16*)(ws + W_MEMVTP) + (size_t)l * 1024 * 256) + (size_t)(b * 4 + h) * 64 * NMEM; a.ldv = NMEM;
      a.gate = (u16*)(ws + W_GATE) + 768 + h * 64;
      a.Tk = NMEM; a.ntiles = 4; a.qpos0 = 0;
      if (samp) { a.qrow0 = MP + b * 16; a.nq = 16; } else { a.qrow0 = b * 4096 + qb * 256; a.nq = 256; }
      attn_item<64, 64, 2>(a, sc_64, smem);
    }
    if ((it == 0 || it == 32 || it == 1600) && !dry) {
      asm volatile("s_waitcnt vmcnt(0)" ::: "memory");
      __syncthreads();
      if (threadIdx.x == 0) {
        __builtin_amdgcn_fence(__ATOMIC_RELEASE, "agent");
        asm volatile("s_waitcnt vmcnt(0)" ::: "memory");
        (void)xb_add(barw + XB_SCNT(l), 1u);
      }
    }
    }
  END_QUEUES
}
DI void phase_p5(const Params& p, int l, unsigned* ctr, int* s_item, char* smem) {
  FOR_QUEUES(q, j, 8 * 4)
    const int kq = 8;
    const int nt = j / kq, ml = j - nt * kq;
    const int mt = q + 8 * ml;
    gemm8_out_tile(p, l, (const u16*)(p.ws + W_WOUT) + (size_t)l * 1024 * GLD, GLD, (const u16*)(p.ws + W_GATE), GLD, 1024, nt * 256, mt * 256, smem, MT);
  END_QUEUES
}
DI void phase_p6(const Params& p, int l, unsigned* ctr, int* s_item) {
  FOR_QUEUES(q, j, (516 - q + 7) / 8)
    ln_rows(p, l, (q + 8 * j) * 32, 32);
  END_QUEUES
}

__global__ void __launch_bounds__(512, 2) mega_kernel(Params p, int ph_begin, int ph_end) {
  __shared__ __attribute__((aligned(16))) char smem_all[SMEM_BYTES + 32];
  char* smem = smem_all;
  uint4& xb_words = *(uint4*)(smem_all + SMEM_BYTES);
  int& s_item = *(int*)(smem_all + SMEM_BYTES + 16);
  unsigned* bar = (unsigned*)(p.ws + W_BAR);
  if (threadIdx.x == 0) xb_words = make_uint4(0u, 0u, 0u, 0u);
  __syncthreads();
  XcdBarrier xb;
  const bool multi = (ph_end - ph_begin) > 1;
  if (multi) xb = xcd_barrier_post(bar, (volatile LAS unsigned*)&xb_words);
  for (int ph = ph_begin; ph < ph_end; ++ph) {
    unsigned* ctr = bar + XB_CTR(ph);
    if (ph == 0) phase_prep(p);
    else {
      const int l = (ph - 1) / 5, k = (ph - 1) % 5;
      if (k == 0) phase_p1(p, l, ctr, &s_item, smem);
      else if (k == 1) phase_p3(p, l, ctr, &s_item, smem);
      else if (k == 2) phase_p4(p, l, ctr, &s_item, smem);
      else if (k == 3) phase_p5(p, l, ctr, &s_item, smem);
      else phase_p6(p, l, ctr, &s_item);
    }
#if PROBE_KIND >= 0
    if (ph > 0 && (ph - 1) % 5 == PROBE_KIND && multi) {
      xcd_barrier(xb);
      const int l = (ph - 1) / 5;
      unsigned* ctr2 = bar + XB_CTR(ph + 16);
      if (PROBE_KIND == 0) phase_p1(p, l, ctr2, &s_item, smem);
      else if (PROBE_KIND == 1) phase_p3(p, l, ctr2, &s_item, smem, true);
      else if (PROBE_KIND == 2) phase_p4(p, l, ctr2, &s_item, smem, p.pad + 1);
      else if (PROBE_KIND == 3 && l == 0) phase_p5(p, l, ctr2, &s_item, smem);
    }
#endif
    if (ph + 1 < ph_end) {
      if (p.use_cg) cg::this_grid().sync();
      else xcd_barrier(xb);
    }
  }
}

extern "C" void kernel_launch(void* const* d_in, const int* in_sizes, int n_in, void* d_out, int out_size, void* d_ws,
                              size_t ws_size, hipStream_t stream) {
  Params p{};
  p.x_prompt = (const float*)d_in[0]; p.x_sample = (const float*)d_in[1];
  p.c_lat = (const float*)d_in[2]; p.c_kr = (const float*)d_in[3]; p.c_fk = (const float*)d_in[4]; p.c_fv = (const float*)d_in[5];
  p.c_logf = (const float*)d_in[6]; p.c_mk = (const float*)d_in[7]; p.c_mv = (const float*)d_in[8];
  p.mem_prompt = (const float*)d_in[9]; p.w_in = (const float*)d_in[10]; p.b_f = (const float*)d_in[11];
  p.qn_g = (const float*)d_in[12]; p.kvn_g = (const float*)d_in[13]; p.w_uq = (const float*)d_in[14]; p.w_ukv = (const float*)d_in[15];
  p.w_memkv = (const float*)d_in[16]; p.w_out = (const float*)d_in[17]; p.ln_g = (const float*)d_in[18]; p.ln_b = (const float*)d_in[19];
  p.out = (float*)d_out; p.ws = (char*)d_ws; p.use_cg = 0; p.pad = 0;
  static int grid_blocks = 0;
  if (!grid_blocks) {
    int dev = 0, cus = 0, per_cu = 0;
    hipGetDevice(&dev);
    hipDeviceGetAttribute(&cus, hipDeviceAttributeMultiprocessorCount, dev);
    hipOccupancyMaxActiveBlocksPerMultiprocessor(&per_cu, mega_kernel, NTH, 0);
    if (per_cu > 1) per_cu = 1;
    if (per_cu < 1) per_cu = 1;
    grid_blocks = cus * per_cu;
  }
  hipMemsetAsync((char*)d_ws + W_BAR, 0, BAR_BYTES, stream);
#if MK_LAUNCHES == 1
  int b = 0, e = NPH;
  void* args[] = {&p, &b, &e};
  hipError_t err = hipLaunchCooperativeKernel((const void*)mega_kernel, dim3(grid_blocks), dim3(NTH), args, 0, stream);
  if (err != hipSuccess) fprintf(stderr, "cooperative launch failed: %s (grid %d)\n", hipGetErrorString(err), grid_blocks);
#else
  for (int ph = 0; ph < NPH; ++ph) mega_kernel<<<dim3(grid_blocks), dim3(NTH), 0, stream>>>(p, ph, ph + 1);
#endif
}
```

```cpp
#include <hip/hip_runtime.h>
#include <hip/hip_cooperative_groups.h>
#include <cstdio>
#include <cstdint>
namespace cg = cooperative_groups;

#ifndef PROBE_KIND
#define PROBE_KIND -1
#endif
#ifndef MK_LAUNCHES
#define MK_LAUNCHES 1
#endif

#define DI __device__ __forceinline__
typedef unsigned short u16;
typedef __attribute__((ext_vector_type(8))) short bf16x8;
typedef __attribute__((ext_vector_type(4))) short s16x4;
typedef __attribute__((ext_vector_type(16))) float f32x16;
typedef __attribute__((ext_vector_type(2))) __bf16 bf2_t;
typedef unsigned u32x4 __attribute__((ext_vector_type(4)));
typedef float f32x4 __attribute__((ext_vector_type(4)));
#define MFMA(a, b, c) __builtin_amdgcn_mfma_f32_32x32x16_bf16((a), (b), (c), 0, 0, 0)

constexpr int D = 1024, BP = 4, TP = 4096, BS = 8, TS = 16, PAST = 2048;
constexpr int MP = BP * TP;
constexpr int MS = BS * TS;
constexpr int MT = MP + MS;
constexpr int TKS = PAST + TS;
constexpr int TAS = 2112;
constexpr int DIN = 2756, N1 = 2816;
constexpr int NMEM = 256;
constexpr float LOG2E = 1.4426950408889634f;
constexpr float EPS = 1e-6f;
constexpr float ALPHA = 1.4142135623730951f;

constexpr int SEG_CQ = 0, SEG_CKV = 384, SEG_KR = 640, SEG_GMLA = 704, SEG_FQ = 1216, SEG_FK = 1472, SEG_FV = 1728,
              SEG_GFOX = 1984, SEG_MQ = 2240, SEG_GMEM = 2496, SEG_FL = 2752;

constexpr size_t O_Y = 0;
constexpr size_t O_PLAT = (size_t)MT * D;
constexpr size_t O_PKR = O_PLAT + (size_t)2 * MP * 256;
constexpr size_t O_PFK = O_PKR + (size_t)2 * MP * 64;
constexpr size_t O_PFV = O_PFK + (size_t)2 * MP * 256;
constexpr size_t O_PLOGF = O_PFV + (size_t)2 * MP * 256;
constexpr size_t O_PMK = O_PLOGF + (size_t)2 * MP * 4;
constexpr size_t O_PMV = O_PMK + (size_t)2 * BP * NMEM * 256;
constexpr size_t O_SLAT = O_PMV + (size_t)2 * BP * NMEM * 256;
constexpr size_t O_SKR = O_SLAT + (size_t)2 * MS * 256;
constexpr size_t O_SFK = O_SKR + (size_t)2 * MS * 64;
constexpr size_t O_SFV = O_SFK + (size_t)2 * MS * 256;
constexpr size_t O_SLOGF = O_SFV + (size_t)2 * MS * 256;
constexpr size_t O_TOTAL = O_SLOGF + (size_t)2 * MS * 4;
static_assert(O_TOTAL == 45564928, "output size");

constexpr size_t al256(size_t x) { return (x + 255) & ~(size_t)255; }
constexpr size_t BAR_BYTES = 32768;
constexpr size_t W_BAR = 0;
constexpr size_t W_TAB = W_BAR + BAR_BYTES;
constexpr size_t W_XB = W_TAB + (size_t)4096 * 32 * 8;
constexpr size_t W_GATE = W_XB + (size_t)MT * 1024 * 2;
constexpr size_t W_CQ = W_GATE + (size_t)(MT + 128) * 1088 * 2;
constexpr size_t W_CKV = W_CQ + (size_t)MT * 384 * 2;
constexpr size_t W_FQ = W_CKV + (size_t)MT * 256 * 2;
constexpr size_t W_MQ = W_FQ + (size_t)MT * 256 * 2;
constexpr size_t W_FKBP = W_MQ + (size_t)MT * 256 * 2;
constexpr size_t W_FVTP = W_FKBP + (size_t)MP * 256 * 2;
constexpr size_t W_KRBP = W_FVTP + (size_t)MP * 256 * 2;
constexpr size_t W_KNP = W_KRBP + (size_t)MP * 64 * 2;
constexpr size_t W_VTP = W_KNP + (size_t)16 * 4096 * 128 * 2;
constexpr size_t W_FKBS = W_VTP + (size_t)16 * 4096 * 128 * 2;
constexpr size_t W_FVTS = W_FKBS + (size_t)BS * TAS * 256 * 2;
constexpr size_t W_KRBS = W_FVTS + (size_t)BS * TAS * 256 * 2;
constexpr size_t W_KNS = W_KRBS + (size_t)BS * TAS * 64 * 2;
constexpr size_t W_VTS = W_KNS + (size_t)32 * TAS * 128 * 2;
constexpr size_t W_MEMKP = W_VTS + (size_t)32 * TAS * 128 * 2;
constexpr size_t W_MEMVTP = W_MEMKP + (size_t)2 * 1024 * 256 * 2;
constexpr size_t W_MEMKS = W_MEMVTP + (size_t)2 * 1024 * 256 * 2;
constexpr size_t W_MEMVTS = W_MEMKS + (size_t)2048 * 256 * 2;
constexpr size_t W_MEMB = W_MEMVTS + (size_t)2048 * 256 * 2;
constexpr size_t W_WIN = W_MEMB + (size_t)1024 * 1024 * 2;
constexpr size_t W_WUQ = W_WIN + (size_t)2 * N1 * 1024 * 2;
constexpr size_t W_WUKV = W_WUQ + (size_t)2 * 768 * 384 * 2;
constexpr size_t W_WUKVF = W_WUKV + (size_t)2 * 1024 * 256 * 2;
constexpr size_t W_WMKV = W_WUKVF + (size_t)2 * 1024 * 256 * 2;
constexpr size_t W_WOUT = W_WMKV + (size_t)2 * 512 * 1024 * 2;
constexpr size_t W_CUMP = W_WOUT + (size_t)2 * 1024 * 1088 * 2;
constexpr size_t W_CUMS = W_CUMP + (size_t)16 * 4096 * 4;
constexpr size_t W_LATC = W_CUMS + (size_t)32 * TAS * 4;
constexpr size_t W_END = W_LATC + (size_t)BS * PAST * 256 * 2;
static_assert(W_END <= (size_t)256 * 1024 * 1024, "workspace too large");

constexpr int GLD = 1088;
constexpr int NPH = 11;
constexpr int NTH = 512;

struct Params {
  const float* x_prompt; const float* x_sample;
  const float* c_lat; const float* c_kr; const float* c_fk; const float* c_fv; const float* c_logf;
  const float* c_mk; const float* c_mv;
  const float* mem_prompt; const float* w_in; const float* b_f; const float* qn_g; const float* kvn_g;
  const float* w_uq; const float* w_ukv; const float* w_memkv; const float* w_out; const float* ln_g; const float* ln_b;
  float* out; char* ws;
  int use_cg; int pad;
};

DI unsigned pk2(float a, float b) { bf2_t v; v[0] = (__bf16)a; v[1] = (__bf16)b; return __builtin_bit_cast(unsigned, v); }
DI void st4bf(u16* p, float a, float b, float c, float d) { *(uint2*)p = make_uint2(pk2(a, b), pk2(c, d)); }
DI float bflo(unsigned u) { return __uint_as_float(u << 16); }
DI float bfhi(unsigned u) { return __uint_as_float(u & 0xffff0000u); }
DI float silu(float x) { return x / (1.f + __expf(-x)); }
DI float ex2(float x) { return __builtin_amdgcn_exp2f(x); }
DI float half_max(float v) { const auto r = __builtin_amdgcn_permlane32_swap(__float_as_uint(v), __float_as_uint(v), false, false); return fmaxf(__uint_as_float(r[0]), __uint_as_float(r[1])); }
DI float half_sum(float v) { const auto r = __builtin_amdgcn_permlane32_swap(__float_as_uint(v), __float_as_uint(v), false, false); return __uint_as_float(r[0]) + __uint_as_float(r[1]); }

DI int tid() { int t = threadIdx.x; asm volatile("" : "+v"(t)); return t; }

#define XB_TMO      128
#define XB_XCNT(j)  (256  + 64 * (j))
#define XB_XSUB(j)  (1280 + 64 * (j))
#define XB_XGEN(j)  (2304 + 64 * (j))
#define XB_TOP      3328
#define XB_TOPGEN   3392
#define XB_CTR(ph)  (4096 + 128 * (ph))
#define XB_SCNT(l)  (7680 + 64 * (l))
#define XB_SPIN_CAP (1u << 22)
#define LAS __attribute__((address_space(3)))
DI unsigned xb_ld(unsigned* p) { return __hip_atomic_load(p, __ATOMIC_RELAXED, __HIP_MEMORY_SCOPE_AGENT); }
DI unsigned xb_add(unsigned* p, unsigned v) { return __hip_atomic_fetch_add(p, v, __ATOMIC_RELAXED, __HIP_MEMORY_SCOPE_AGENT); }
DI unsigned xb_xcc_id() { return (unsigned)__builtin_amdgcn_s_getreg((3 << 11) | 20) & 0xFu; }
#define XB_SPIN(cond, bar) do { unsigned _sp = 0; while (cond) { __builtin_amdgcn_s_sleep(1); \
    if ((++_sp & 255u) == 0u) { if (xb_ld(&(bar)[XB_TMO])) break; if (_sp > XB_SPIN_CAP) { atomicAdd(&(bar)[XB_TMO], 1u); break; } } } } while (0)
struct XcdBarrier { unsigned* bar; unsigned x; volatile LAS unsigned* st; };
DI XcdBarrier xcd_barrier_post(unsigned* bar, volatile LAS unsigned* st) {
  XcdBarrier b; b.bar = bar; b.x = xb_xcc_id(); b.st = st;
  if (threadIdx.x == 0) (void)xb_add(&bar[XB_XCNT(b.x)], 1u);
  return b;
}
DI void xcd_barrier_complete(unsigned* bar, unsigned x, unsigned& nloc, unsigned& nx) {
  const unsigned G = gridDim.x * gridDim.y * gridDim.z;
  unsigned sum, cnt, mine, sp = 0u;
  for (;;) {
    sum = 0u; cnt = 0u; mine = 0u;
#pragma unroll
    for (unsigned j = 0; j < 16; ++j) { const unsigned c = xb_ld(&bar[XB_XCNT(j)]); sum += c; cnt += (c > 0u) ? 1u : 0u; mine = (j == x) ? c : mine; }
    if (sum == G) break;
    __builtin_amdgcn_s_sleep(1);
    if ((++sp & 255u) == 0u) { if (xb_ld(&bar[XB_TMO])) break; if (sp > XB_SPIN_CAP) { atomicAdd(&bar[XB_TMO], 1u); break; } }
  }
  nloc = mine > 0u ? mine : 1u; nx = cnt > 0u ? cnt : 1u;
}
DI void xcd_barrier(XcdBarrier b) {
  asm volatile("s_waitcnt vmcnt(0)" ::: "memory");
  __syncthreads();
  if (threadIdx.x == 0) {
    unsigned* bar = b.bar;
    asm volatile("" : "+s"(bar));
    b.x = xb_xcc_id();
    __builtin_amdgcn_s_waitcnt(0);
    unsigned nloc = b.st[0], nx = b.st[1];
    if (nloc == 0u) { xcd_barrier_complete(bar, b.x, nloc, nx); b.st[0] = nloc; b.st[1] = nx; }
    const unsigned old = xb_add(&bar[XB_XSUB(b.x)], 1u);
    const unsigned gen = old / nloc;
    if (old + 1u == (gen + 1u) * nloc) {
      __builtin_amdgcn_fence(__ATOMIC_RELEASE, "agent");
      asm volatile("s_waitcnt vmcnt(0)" ::: "memory");
      const unsigned og = xb_add(&bar[XB_TOP], 1u);
      const unsigned tg = og / nx;
      if (og + 1u == (tg + 1u) * nx) xb_add(&bar[XB_TOPGEN], 1u);
      else XB_SPIN(xb_ld(&bar[XB_TOPGEN]) == tg, bar);
      __builtin_amdgcn_fence(__ATOMIC_ACQUIRE, "agent");
      xb_add(&bar[XB_XGEN(b.x)], 1u);
      asm volatile("s_waitcnt vmcnt(0)" ::: "memory");
    } else {
      XB_SPIN(xb_ld(&bar[XB_XGEN(b.x)]) == gen, bar);
      __builtin_amdgcn_fence(__ATOMIC_ACQUIRE, "agent");
      asm volatile("s_waitcnt vmcnt(0)" ::: "memory");
    }
  }
  __syncthreads();
}

constexpr int LDT = 72;
constexpr int GEMM_BUF = 2 * 256 * LDT;
constexpr int SMEM_BYTES = 2 * GEMM_BUF * 2 + 1024;
DI int pop_item(unsigned* ctrs, int q, int* s_item) {
  __syncthreads();
  if (threadIdx.x == 0) *s_item = (int)atomicAdd(ctrs + q * 16, 1u);
  __syncthreads();
  return *s_item;
}
#define FOR_QUEUES(q, j, NQ_EXPR) \
  for (int qq_ = 0, x0_ = (int)(xb_xcc_id() & 7u); qq_ < 8; ++qq_) { const int q = (x0_ + qq_) & 7; const int nq_ = (NQ_EXPR); \
    for (;;) { const int j = pop_item(ctr, q, s_item); if (j >= nq_) break;
#define END_QUEUES }}
DI int q_mtiles(int q, int mtiles) { return (mtiles - q + 7) >> 3; }

DI int wi_colmap(int n) {
  if (n < 1984) return n;
  if (n < 2752) return n + 4;
  if (n < 2756) return 1984 + (n - 2752);
  return -1;
}
DI void transpose_w(const float* __restrict__ src, int Nsrc, u16* __restrict__ dst, int Npad, int K, bool permute,
                    const float* __restrict__ g, int gt, int nth, int ldd = 0) {
  if (ldd == 0) ldd = K;
  const int total = Npad * (K >> 3);
  for (int i = gt; i < total; i += nth) {
    const int n = i % Npad, k8 = i / Npad;
    const int on = permute ? wi_colmap(n) : n;
    float v[8];
#pragma unroll
    for (int j = 0; j < 8; ++j) {
      float x = (on >= 0) ? src[(size_t)(k8 * 8 + j) * Nsrc + on] : 0.f;
      if (g) x *= g[k8 * 8 + j];
      v[j] = x;
    }
    *(uint4*)(dst + (size_t)n * ldd + k8 * 8) = make_uint4(pk2(v[0], v[1]), pk2(v[2], v[3]), pk2(v[4], v[5]), pk2(v[6], v[7]));
  }
}
DI void convert8(const float* __restrict__ src, u16* __restrict__ dst) {
  const float4 a = ((const float4*)src)[0], b = ((const float4*)src)[1];
  *(uint4*)dst = make_uint4(pk2(a.x, a.y), pk2(a.z, a.w), pk2(b.x, b.y), pk2(b.z, b.w));
}

DI void phase_prep(const Params& p) {
  const int nth = gridDim.x * NTH, gt = blockIdx.x * NTH + tid();
  char* ws = p.ws;
  u16* Xb = (u16*)(ws + W_XB);
  for (int i = gt; i < MT * D / 8; i += nth) {
    const size_t e = (size_t)i * 8;
    const float* src = e < (size_t)MP * D ? p.x_prompt + e : p.x_sample + (e - (size_t)MP * D);
    convert8(src, Xb + e);
  }
  u16* memb = (u16*)(ws + W_MEMB);
  for (int i = gt; i < 1024 * 1024 / 8; i += nth) convert8(p.mem_prompt + (size_t)i * 8, memb + (size_t)i * 8);
  for (int l = 0; l < 2; ++l) {
    transpose_w(p.w_in + (size_t)l * D * DIN, DIN, (u16*)(ws + W_WIN) + (size_t)l * N1 * 1024, N1, 1024, true, nullptr, gt, nth);
    transpose_w(p.w_uq + (size_t)l * 384 * 768, 768, (u16*)(ws + W_WUQ) + (size_t)l * 768 * 384, 768, 384, false, p.qn_g + l * 384, gt, nth);
    transpose_w(p.w_ukv + (size_t)l * 256 * 1024, 1024, (u16*)(ws + W_WUKV) + (size_t)l * 1024 * 256, 1024, 256, false, nullptr, gt, nth);
    transpose_w(p.w_ukv + (size_t)l * 256 * 1024, 1024, (u16*)(ws + W_WUKVF) + (size_t)l * 1024 * 256, 1024, 256, false, p.kvn_g + l * 256, gt, nth);
    transpose_w(p.w_memkv + (size_t)l * 1024 * 512, 512, (u16*)(ws + W_WMKV) + (size_t)l * 512 * 1024, 512, 1024, false, nullptr, gt, nth);
    transpose_w(p.w_out + (size_t)l * 1024 * 1024, 1024, (u16*)(ws + W_WOUT) + (size_t)l * 1024 * GLD, 1024, 1024, false, nullptr, gt, nth, GLD);
  }
  float2* tab = (float2*)(ws + W_TAB);
  for (int i = gt; i < 4096 * 32; i += nth) {
    const int pos = i >> 5, c = i & 31;
    const float inv = powf(10000.f, -(float)c / 32.f);
    const float ang = (float)pos * inv;
    float s, co; sincosf(ang, &s, &co);
    tab[i] = make_float2(co, s);
  }
}

DI void phase_cacheconv(const Params& p, int l) {
  const int nth = gridDim.x * NTH, gt = blockIdx.x * NTH + tid();
  char* ws = p.ws;
  {
    const float* src = p.c_fk + (size_t)l * BS * PAST * 256; u16* dst = (u16*)(ws + W_FKBS);
    for (int i = gt; i < BS * PAST * 256 / 8; i += nth) {
      const int c8 = i & 31, bt = i >> 5, b = bt >> 11, t = bt & 2047;
      convert8(src + (size_t)i * 8, dst + ((size_t)(b * TAS + t) * 256 + c8 * 8));
    }
  }
  {
    const float* src = p.c_lat + (size_t)l * BS * PAST * 256; u16* dst = (u16*)(ws + W_LATC);
    for (int i = gt; i < BS * PAST * 256 / 8; i += nth) convert8(src + (size_t)i * 8, dst + (size_t)i * 8);
  }
  {
    const float* src = p.c_kr + (size_t)l * BS * PAST * 64; u16* dst = (u16*)(ws + W_KRBS);
    for (int i = gt; i < BS * PAST * 64 / 8; i += nth) {
      const int c8 = i & 7, bt = i >> 3, b = bt >> 11, t = bt & 2047;
      convert8(src + (size_t)i * 8, dst + ((size_t)(b * TAS + t) * 64 + c8 * 8));
    }
  }
  {
    const float* src = p.c_mk + (size_t)l * BS * NMEM * 256; u16* dst = (u16*)(ws + W_MEMKS);
    for (int i = gt; i < BS * NMEM * 256 / 8; i += nth) convert8(src + (size_t)i * 8, dst + (size_t)i * 8);
  }
  {
    const float* src = p.c_fv + (size_t)l * BS * PAST * 256; u16* dst = (u16*)(ws + W_FVTS);
    for (int i = gt; i < BS * (PAST / 8) * 256; i += nth) {
      const int c = i & 255, t8 = (i >> 8) & 255, b = i >> 16;
      float v[8];
#pragma unroll
      for (int j = 0; j < 8; ++j) v[j] = src[((size_t)(b * PAST + t8 * 8 + j)) * 256 + c];
      *(uint4*)(dst + ((size_t)(b * 256 + c) * TAS + t8 * 8)) = make_uint4(pk2(v[0], v[1]), pk2(v[2], v[3]), pk2(v[4], v[5]), pk2(v[6], v[7]));
    }
  }
  {
    const float* src = p.c_mv + (size_t)l * BS * NMEM * 256; u16* dst = (u16*)(ws + W_MEMVTS);
    for (int i = gt; i < BS * (NMEM / 8) * 256; i += nth) {
      const int c = i & 255, t8 = (i >> 8) & 31, b = i >> 13;
      float v[8];
#pragma unroll
      for (int j = 0; j < 8; ++j) v[j] = src[((size_t)(b * NMEM + t8 * 8 + j)) * 256 + c];
      *(uint4*)(dst + ((size_t)(b * 256 + c) * NMEM + t8 * 8)) = make_uint4(pk2(v[0], v[1]), pk2(v[2], v[3]), pk2(v[4], v[5]), pk2(v[6], v[7]));
    }
  }
}

template <bool AF32>
DI void gemm_gload(const void* __restrict__ Aptr, int lda, const u16* __restrict__ Bt, int ldb, int m0, int n0, int k0,
                   unsigned offA, unsigned offB, u32x4 (&ra)[4], u32x4 (&rb)[4], f32x4 (&rf)[8]) {
  constexpr int ES = AF32 ? 4 : 2;
  const char* ab = (const char*)Aptr + ((size_t)m0 * lda + k0) * ES;
  const char* bb = (const char*)Bt + ((size_t)n0 * ldb + k0) * 2;
#pragma unroll
  for (int i = 0; i < 4; ++i) {
    if constexpr (AF32) {
      const char* s = ab + (size_t)i * 64 * lda * 4 + offA;
      rf[2 * i] = *(const f32x4*)s; rf[2 * i + 1] = *(const f32x4*)(s + 16);
    } else {
      ra[i] = *(const u32x4*)(ab + (size_t)i * 64 * lda * 2 + offA);
    }
    rb[i] = *(const u32x4*)(bb + (size_t)i * 64 * ldb * 2 + offB);
  }
}
template <bool AF32, bool SSQ>
DI void gemm_mainloop(const void* __restrict__ Aptr, int lda, const u16* __restrict__ Bt, int ldb, int K, int m0, int n0,
                      char* smem, f32x16 (&acc)[4][2]) {
  u16* As = (u16*)smem; u16* Bs = As + 256 * LDT; float* rs_lds = (float*)(smem + 2 * GEMM_BUF * 2);
  const int t = tid(), lane = t & 63, w = t >> 6, g = lane >> 5, r = lane & 31;
  const int wm = w >> 2, wn = w & 3;
  const int lrow = t >> 3, lkc = t & 7;
  if constexpr (SSQ) {
    const int row = t >> 1, half = t & 1, kh = K >> 1;
    const u16* ap = (const u16*)Aptr + (size_t)(m0 + row) * lda + half * kh;
    float s = 0.f;
    for (int c = 0; c < kh; c += 8) {
      const u32x4 u = *(const u32x4*)(ap + c);
      s += bflo(u.x) * bflo(u.x) + bfhi(u.x) * bfhi(u.x) + bflo(u.y) * bflo(u.y) + bfhi(u.y) * bfhi(u.y);
      s += bflo(u.z) * bflo(u.z) + bfhi(u.z) * bfhi(u.z) + bflo(u.w) * bflo(u.w) + bfhi(u.w) * bfhi(u.w);
    }
    s += __shfl_xor(s, 1);
    if (half == 0) rs_lds[row] = rsqrtf(s / (float)K + EPS);
  }
  u32x4 ra[4], rb[4];
  f32x4 rf[8];
#pragma unroll
  for (int mi = 0; mi < 4; ++mi)
#pragma unroll
    for (int ni = 0; ni < 2; ++ni)
#pragma unroll
      for (int i = 0; i < 16; ++i) acc[mi][ni][i] = 0.f;

  const int KT = K >> 6;
  const unsigned offA = (unsigned)(lrow * lda + lkc * 8) * (AF32 ? 4u : 2u);
  const unsigned offB = (unsigned)(lrow * ldb + lkc * 8) * 2u;
  gemm_gload<AF32>(Aptr, lda, Bt, ldb, m0, n0, 0, offA, offB, ra, rb, rf);
  for (int kt = -1; kt < KT; ++kt) {
    if (kt + 1 < KT) {
      u16* Aw = As + ((kt + 1) & 1) * GEMM_BUF;
      u16* Bw = Bs + ((kt + 1) & 1) * GEMM_BUF;
#pragma unroll
      for (int i = 0; i < 4; ++i) {
        const int row = lrow + 64 * i;
        if constexpr (AF32) {
          const f32x4 a = rf[2 * i], b = rf[2 * i + 1];
          ra[i] = u32x4{pk2(a.x, a.y), pk2(a.z, a.w), pk2(b.x, b.y), pk2(b.z, b.w)};
        }
        *(u32x4*)(Aw + row * LDT + lkc * 8) = ra[i];
        *(u32x4*)(Bw + row * LDT + lkc * 8) = rb[i];
      }
      if (kt + 2 < KT) gemm_gload<AF32>(Aptr, lda, Bt, ldb, m0, n0, (kt + 2) << 6, offA, offB, ra, rb, rf);
    }
    __builtin_amdgcn_sched_barrier(0);
    if (kt >= 0) {
      const u16* Ar = As + (kt & 1) * GEMM_BUF;
      const u16* Br = Bs + (kt & 1) * GEMM_BUF;
#pragma unroll
      for (int ks = 0; ks < 4; ++ks) {
        bf16x8 wf[2], xf[4];
#pragma unroll
        for (int ni = 0; ni < 2; ++ni) wf[ni] = *(const bf16x8*)(Br + (wn * 64 + ni * 32 + r) * LDT + ks * 16 + g * 8);
#pragma unroll
        for (int mi = 0; mi < 4; ++mi) xf[mi] = *(const bf16x8*)(Ar + (wm * 128 + mi * 32 + r) * LDT + ks * 16 + g * 8);
#pragma unroll
        for (int mi = 0; mi < 4; ++mi)
#pragma unroll
          for (int ni = 0; ni < 2; ++ni) acc[mi][ni] = MFMA(wf[ni], xf[mi], acc[mi][ni]);
      }
    }
    __syncthreads();
  }
}

enum { EPI_H = 0, EPI_MEMKV = 1, EPI_Q = 2, EPI_KV = 3, EPI_KVC = 4, EPI_OUT = 5 };

template <int EPI>
DI void gemm_epilogue(const Params& p, int l, f32x16 (&acc)[4][2], int m0, int n0, char* smem, int mrows) {
  const float* rs_lds = (const float*)(smem + 2 * GEMM_BUF * 2);
  const int t = tid(), lane = t & 63, w = t >> 6, g = lane >> 5, r = lane & 31;
  const int wm = w >> 2, wn = w & 3;
  const int nw = n0 + wn * 64;
  char* ws = p.ws; float* out = p.out;
  const float2* tab = (const float2*)(ws + W_TAB);
#pragma unroll
  for (int mi = 0; mi < 4; ++mi) {
    const int lr = wm * 128 + mi * 32 + r;
    const int row = m0 + lr;
    if (row >= mrows) continue;
    if constexpr (EPI == EPI_H) {
      const bool is_s = row >= MP;
      const int b = is_s ? ((row - MP) >> 4) : (row >> 12);
      const int tt = is_s ? ((row - MP) & 15) : (row & 4095);
      if (nw < SEG_CKV) {
        u16* d = (u16*)(ws + W_CQ) + (size_t)row * 384;
#pragma unroll
        for (int ni = 0; ni < 2; ++ni)
#pragma unroll
          for (int j = 0; j < 4; ++j) { const int n = nw + ni * 32 + 8 * j + 4 * g; st4bf(d + n, acc[mi][ni][4 * j], acc[mi][ni][4 * j + 1], acc[mi][ni][4 * j + 2], acc[mi][ni][4 * j + 3]); }
      } else if (nw < SEG_KR) {
        u16* d = (u16*)(ws + W_CKV) + (size_t)row * 256;
        float* lo = is_s ? out + O_SLAT + (size_t)l * MS * 256 + (size_t)(row - MP) * 256 : out + O_PLAT + (size_t)l * MP * 256 + (size_t)row * 256;
#pragma unroll
        for (int ni = 0; ni < 2; ++ni)
#pragma unroll
          for (int j = 0; j < 4; ++j) {
            const int c = nw - SEG_CKV + ni * 32 + 8 * j + 4 * g;
            st4bf(d + c, acc[mi][ni][4 * j], acc[mi][ni][4 * j + 1], acc[mi][ni][4 * j + 2], acc[mi][ni][4 * j + 3]);
            *(float4*)(lo + c) = make_float4(acc[mi][ni][4 * j], acc[mi][ni][4 * j + 1], acc[mi][ni][4 * j + 2], acc[mi][ni][4 * j + 3]);
          }
      } else if (nw == SEG_KR) {
        const int pos = is_s ? PAST + tt : tt;
        float* ko = is_s ? out + O_SKR + (size_t)l * MS * 64 + (size_t)(row - MP) * 64 : out + O_PKR + (size_t)l * MP * 64 + (size_t)row * 64;
        u16* kb = is_s ? (u16*)(ws + W_KRBS) + (size_t)(b * TAS + PAST + tt) * 64 : (u16*)(ws + W_KRBP) + (size_t)row * 64;
#pragma unroll
        for (int j = 0; j < 4; ++j) {
          const int c = 8 * j + 4 * g;
          float y1[4], y2[4];
#pragma unroll
          for (int i = 0; i < 4; ++i) {
            const float2 cs = tab[pos * 32 + c + i];
            const float x1 = acc[mi][0][4 * j + i], x2 = acc[mi][1][4 * j + i];
            y1[i] = x1 * cs.x - x2 * cs.y; y2[i] = x1 * cs.y + x2 * cs.x;
          }
          *(float4*)(ko + c) = make_float4(y1[0], y1[1], y1[2], y1[3]);
          *(float4*)(ko + 32 + c) = make_float4(y2[0], y2[1], y2[2], y2[3]);
          st4bf(kb + c, y1[0], y1[1], y1[2], y1[3]);
          st4bf(kb + 32 + c, y2[0], y2[1], y2[2], y2[3]);
          __builtin_amdgcn_sched_barrier(0);
        }
      } else if (nw < SEG_FQ || (nw >= SEG_GFOX && nw < SEG_MQ) || (nw >= SEG_GMEM && nw < SEG_FL)) {
        const int gc0 = nw < SEG_FQ ? nw - SEG_GMLA : (nw < SEG_MQ ? 512 + nw - SEG_GFOX : 768 + nw - SEG_GMEM);
        u16* d = (u16*)(ws + W_GATE) + (size_t)row * GLD + gc0;
#pragma unroll
        for (int ni = 0; ni < 2; ++ni)
#pragma unroll
          for (int j = 0; j < 4; ++j) {
            const int c = ni * 32 + 8 * j + 4 * g;
            st4bf(d + c, silu(acc[mi][ni][4 * j]), silu(acc[mi][ni][4 * j + 1]), silu(acc[mi][ni][4 * j + 2]), silu(acc[mi][ni][4 * j + 3]));
          }
      } else if (nw < SEG_FK) {
        u16* d = (u16*)(ws + W_FQ) + (size_t)row * 256 + (nw - SEG_FQ);
#pragma unroll
        for (int ni = 0; ni < 2; ++ni)
#pragma unroll
          for (int j = 0; j < 4; ++j) { const int c = ni * 32 + 8 * j + 4 * g; st4bf(d + c, acc[mi][ni][4 * j], acc[mi][ni][4 * j + 1], acc[mi][ni][4 * j + 2], acc[mi][ni][4 * j + 3]); }
      } else if (nw < SEG_FV) {
        const int c0 = nw - SEG_FK;
        float* fo = (is_s ? out + O_SFK + (size_t)l * MS * 256 + (size_t)(row - MP) * 256 : out + O_PFK + (size_t)l * MP * 256 + (size_t)row * 256) + c0;
        u16* d = (is_s ? (u16*)(ws + W_FKBS) + (size_t)(b * TAS + PAST + tt) * 256 : (u16*)(ws + W_FKBP) + (size_t)row * 256) + c0;
#pragma unroll
        for (int ni = 0; ni < 2; ++ni)
#pragma unroll
          for (int j = 0; j < 4; ++j) {
            const int c = ni * 32 + 8 * j + 4 * g;
            *(float4*)(fo + c) = make_float4(acc[mi][ni][4 * j], acc[mi][ni][4 * j + 1], acc[mi][ni][4 * j + 2], acc[mi][ni][4 * j + 3]);
            st4bf(d + c, acc[mi][ni][4 * j], acc[mi][ni][4 * j + 1], acc[mi][ni][4 * j + 2], acc[mi][ni][4 * j + 3]);
          }
      } else if (nw < SEG_GFOX) {
        const int c0 = nw - SEG_FV;
        float* fo = (is_s ? out + O_SFV + (size_t)l * MS * 256 + (size_t)(row - MP) * 256 : out + O_PFV + (size_t)l * MP * 256 + (size_t)row * 256) + c0;
        u16* d = is_s ? (u16*)(ws + W_FVTS) + (size_t)(b * 256 + c0) * TAS + PAST + tt : (u16*)(ws + W_FVTP) + (size_t)(b * 256 + c0) * 4096 + tt;
        const size_t ldt = is_s ? TAS : 4096;
#pragma unroll
        for (int ni = 0; ni < 2; ++ni)
#pragma unroll
          for (int j = 0; j < 4; ++j) {
            const int c = ni * 32 + 8 * j + 4 * g;
            *(float4*)(fo + c) = make_float4(acc[mi][ni][4 * j], acc[mi][ni][4 * j + 1], acc[mi][ni][4 * j + 2], acc[mi][ni][4 * j + 3]);
#pragma unroll
            for (int i = 0; i < 4; ++i) d[(size_t)(c + i) * ldt] = (u16)(pk2(acc[mi][ni][4 * j + i], 0.f) & 0xffffu);
          }
      } else if (nw < SEG_GMEM) {
        u16* d = (u16*)(ws + W_MQ) + (size_t)row * 256 + (nw - SEG_MQ);
#pragma unroll
        for (int ni = 0; ni < 2; ++ni)
#pragma unroll
          for (int j = 0; j < 4; ++j) { const int c = ni * 32 + 8 * j + 4 * g; st4bf(d + c, acc[mi][ni][4 * j], acc[mi][ni][4 * j + 1], acc[mi][ni][4 * j + 2], acc[mi][ni][4 * j + 3]); }
      } else {
        if (g == 0) {
          float lf[4];
#pragma unroll
          for (int i = 0; i < 4; ++i) {
            const float z = acc[mi][0][i] + p.b_f[l * 4 + i];
            lf[i] = fminf(z, 0.f) - log1pf(expf(-fabsf(z)));
          }
          float* fo = is_s ? out + O_SLOGF + (size_t)l * MS * 4 + (size_t)(row - MP) * 4 : out + O_PLOGF + (size_t)l * MP * 4 + (size_t)row * 4;
          *(float4*)fo = make_float4(lf[0], lf[1], lf[2], lf[3]);
        }
      }
    } else if constexpr (EPI == EPI_MEMKV) {
      const int b = row >> 8, m = row & 255;
#pragma unroll
      for (int ni = 0; ni < 2; ++ni)
#pragma unroll
        for (int j = 0; j < 4; ++j) {
          const int n = nw + ni * 32 + 8 * j + 4 * g;
          const float4 v = make_float4(acc[mi][ni][4 * j], acc[mi][ni][4 * j + 1], acc[mi][ni][4 * j + 2], acc[mi][ni][4 * j + 3]);
          if (nw < 256) {
            *(float4*)(out + O_PMK + (size_t)l * 1024 * 256 + (size_t)row * 256 + n) = v;
            st4bf((u16*)(ws + W_MEMKP) + (size_t)l * 1024 * 256 + (size_t)row * 256 + n, v.x, v.y, v.z, v.w);
          } else {
            const int c = n - 256;
            *(float4*)(out + O_PMV + (size_t)l * 1024 * 256 + (size_t)row * 256 + c) = v;
            u16* d = (u16*)(ws + W_MEMVTP) + (size_t)l * 1024 * 256 + (size_t)(b * 256 + c) * NMEM + m;
            d[0] = (u16)(pk2(v.x, 0.f) & 0xffffu); d[NMEM] = (u16)(pk2(v.y, 0.f) & 0xffffu);
            d[2 * NMEM] = (u16)(pk2(v.z, 0.f) & 0xffffu); d[3 * NMEM] = (u16)(pk2(v.w, 0.f) & 0xffffu);
          }
        }
    } else if constexpr (EPI == EPI_Q) {
      const float rs = rs_lds[lr];
      const bool is_s = row >= MP;
      const int tt = is_s ? ((row - MP) & 15) : (row & 4095);
      const int pos = is_s ? PAST + tt : tt;
      u16* d = (u16*)(ws + W_XB) + (size_t)row * 768 + nw;
      if ((nw % 192) == 128) {
#pragma unroll
        for (int j = 0; j < 4; ++j) {
          const int c = 8 * j + 4 * g;
          float y1[4], y2[4];
#pragma unroll
          for (int i = 0; i < 4; ++i) {
            const float2 cs = tab[pos * 32 + c + i];
            const float x1 = acc[mi][0][4 * j + i] * rs, x2 = acc[mi][1][4 * j + i] * rs;
            y1[i] = x1 * cs.x - x2 * cs.y; y2[i] = x1 * cs.y + x2 * cs.x;
          }
          st4bf(d + c, y1[0], y1[1], y1[2], y1[3]);
          st4bf(d + 32 + c, y2[0], y2[1], y2[2], y2[3]);
          __builtin_amdgcn_sched_barrier(0);
        }
      } else {
#pragma unroll
        for (int ni = 0; ni < 2; ++ni)
#pragma unroll
          for (int j = 0; j < 4; ++j) {
            const int c = ni * 32 + 8 * j + 4 * g;
            st4bf(d + c, acc[mi][ni][4 * j] * rs, acc[mi][ni][4 * j + 1] * rs, acc[mi][ni][4 * j + 2] * rs, acc[mi][ni][4 * j + 3] * rs);
          }
      }
    } else if constexpr (EPI == EPI_KV || EPI == EPI_KVC) {
      float rs = 1.f; int b, tt; bool is_s;
      if constexpr (EPI == EPI_KV) {
        rs = rs_lds[lr]; is_s = row >= MP;
        b = is_s ? ((row - MP) >> 4) : (row >> 12);
        tt = is_s ? PAST + ((row - MP) & 15) : (row & 4095);
      } else { is_s = true; b = row >> 11; tt = row & 2047; }
      const int head = nw >> 8, c0 = nw & 255;
      const size_t T = is_s ? TAS : 4096;
      u16* knb = (u16*)(ws + (is_s ? W_KNS : W_KNP)); u16* vtb = (u16*)(ws + (is_s ? W_VTS : W_VTP));
      if (c0 < 128) {
        u16* d = knb + ((size_t)(b * 4 + head) * T + tt) * 128 + c0;
#pragma unroll
        for (int ni = 0; ni < 2; ++ni)
#pragma unroll
          for (int j = 0; j < 4; ++j) {
            const int c = ni * 32 + 8 * j + 4 * g;
            st4bf(d + c, acc[mi][ni][4 * j] * rs, acc[mi][ni][4 * j + 1] * rs, acc[mi][ni][4 * j + 2] * rs, acc[mi][ni][4 * j + 3] * rs);
          }
      } else {
        u16* d = vtb + ((size_t)(b * 4 + head) * 128 + (c0 - 128)) * T + tt;
#pragma unroll
        for (int ni = 0; ni < 2; ++ni)
#pragma unroll
          for (int j = 0; j < 4; ++j) {
            const int c = ni * 32 + 8 * j + 4 * g;
#pragma unroll
            for (int i = 0; i < 4; ++i) d[(size_t)(c + i) * T] = (u16)(pk2(acc[mi][ni][4 * j + i] * rs, 0.f) & 0xffffu);
          }
      }
    } else if constexpr (EPI == EPI_OUT) {
      const float* res = (l == 0) ? (row < MP ? p.x_prompt + (size_t)row * 1024 : p.x_sample + (size_t)(row - MP) * 1024) : out + O_Y + (size_t)row * 1024;
      float* zo = out + O_Y + (size_t)row * 1024;
#pragma unroll
      for (int ni = 0; ni < 2; ++ni)
#pragma unroll
        for (int j = 0; j < 4; ++j) {
          const int n = nw + ni * 32 + 8 * j + 4 * g;
          const float4 x = *(const float4*)(res + n);
          *(float4*)(zo + n) = make_float4(ALPHA * x.x + acc[mi][ni][4 * j], ALPHA * x.y + acc[mi][ni][4 * j + 1],
                                           ALPHA * x.z + acc[mi][ni][4 * j + 2], ALPHA * x.w + acc[mi][ni][4 * j + 3]);
        }
    }
  }
}

template <bool AF32, bool SSQ, int EPI>
DI void gemm_tile(const Params& p, int l, const void* A, int lda, const u16* Bt, int ldb, int K, int m0, int n0, char* smem, int mrows) {
  f32x16 acc[4][2];
  gemm_mainloop<AF32, SSQ>(A, lda, Bt, ldb, K, m0, n0, smem, acc);
  gemm_epilogue<EPI>(p, l, acc, m0, n0, smem, mrows);
}

typedef __attribute__((ext_vector_type(4))) float g8f4;
constexpr int G8_HALF = 128, G8_BK = 64, G8_HT = G8_HALF * G8_BK;
DI int g8_lds_byte(int r, int c) {
  int st = (r >> 4) * 2 + (c >> 5), rr = r & 15, cc = c & 31, ob = rr * 64 + cc * 2;
  return st * 1024 + (ob ^ (((ob >> 9) & 1) << 5));
}
DI void g8_stage_rc(int b, int& R, int& C) {
  int st = b / 1024, sb = b % 1024, swz = sb ^ (((sb >> 9) & 1) << 5);
  R = (st >> 1) * 16 + swz / 64; C = (st & 1) * 32 + (swz % 64) / 2;
}
DI void gemm8_mainloop(const u16* __restrict__ W, int ldw, const u16* __restrict__ X, int ldx, int K,
                       int brow, int bcol, char* smem, g8f4 (&acc)[2][2][4][2]) {
  u16* shm = (u16*)smem;
  #define SA(b,h) (shm+((b)*2+(h))*G8_HT)
  #define SB(b,h) (shm+(4+(b)*2+(h))*G8_HT)
  #define STAGE(P,BASE,LD,br,kt) do{long _g=(long)(br)*(LD)+(long)(kt)*G8_BK; \
    for(int _i=0;_i<2;++_i){int _b=tx*16+_i*8192;int _r,_c;g8_stage_rc(_b,_r,_c); \
      __builtin_amdgcn_global_load_lds((const unsigned*)(BASE+_g+(long)_r*(LD)+_c), \
        (__attribute__((address_space(3))) unsigned*)((char*)(P)+_b),16,0,0);}}while(0)
  #define LDA(dst,b,h) for(int m=0;m<4;++m)for(int k=0;k<2;++k) \
    dst[m][k]=*reinterpret_cast<const bf16x8*>((char*)SA(b,h)+g8_lds_byte(wr*64+m*16+fr,k*32+fq*8))
  #define LDB(dst,b,h) for(int n=0;n<2;++n)for(int k=0;k<2;++k) \
    dst[n][k]=*reinterpret_cast<const bf16x8*>((char*)SB(b,h)+g8_lds_byte(wc*32+n*16+fr,k*32+fq*8))
  #define MMA(ai,bj,At,Bt) do{__builtin_amdgcn_s_setprio(1); \
    for(int m=0;m<4;++m)for(int n=0;n<2;++n)for(int k=0;k<2;++k) \
      acc[ai][bj][m][n]=__builtin_amdgcn_mfma_f32_16x16x32_bf16(At[m][k],Bt[n][k],acc[ai][bj][m][n],0,0,0); \
    __builtin_amdgcn_s_setprio(0);}while(0)
  #define WAIT_V(n) asm volatile("s_waitcnt vmcnt(" #n ")":::"memory")
  #define WAIT_L(n) asm volatile("s_waitcnt lgkmcnt(" #n ")":::"memory")
  #define BAR __builtin_amdgcn_s_barrier()
  #define SCHED __builtin_amdgcn_sched_barrier(0)
  const int tx = tid();
  const int wid = tx >> 6, lane = tx & 63, wr = wid >> 2, wc = wid & 3, fr = lane & 15, fq = lane >> 4;
#pragma unroll
  for (int a_ = 0; a_ < 2; ++a_)
#pragma unroll
    for (int b_ = 0; b_ < 2; ++b_)
#pragma unroll
      for (int m = 0; m < 4; ++m)
#pragma unroll
        for (int n = 0; n < 2; ++n) acc[a_][b_][m][n] = g8f4{0.f, 0.f, 0.f, 0.f};
  bf16x8 At[4][2], B0[2][2], B1[2][2];
  const int nt = K / G8_BK;
  const u16* A = W; const u16* Bt = X;
  STAGE(SB(0,0),Bt,ldx,bcol,0); STAGE(SA(0,0),A,ldw,brow,0);
  STAGE(SB(0,1),Bt,ldx,bcol+G8_HALF,0); STAGE(SA(0,1),A,ldw,brow+G8_HALF,0);
  if(wr==1)BAR;
  WAIT_V(4); BAR;
  STAGE(SB(1,0),Bt,ldx,bcol,1); STAGE(SA(1,0),A,ldw,brow,1); STAGE(SB(1,1),Bt,ldx,bcol+G8_HALF,1);
  WAIT_V(6); BAR;
  for(int t=0;t<nt-2;t+=2){
    LDB(B0,0,0); SCHED; LDA(At,0,0); STAGE(SA(1,1),A,ldw,brow+G8_HALF,t+1);
    WAIT_L(8); BAR; WAIT_L(0); MMA(0,0,At,B0); BAR; SCHED;
    LDB(B1,0,1); STAGE(SB(0,0),Bt,ldx,bcol,t+2);
    BAR; WAIT_L(0); MMA(0,1,At,B1); BAR;
    LDA(At,0,1); STAGE(SA(0,0),A,ldw,brow,t+2);
    BAR; WAIT_L(0); MMA(1,0,At,B0); BAR; SCHED;
    STAGE(SB(0,1),Bt,ldx,bcol+G8_HALF,t+2);
    WAIT_V(6); BAR; MMA(1,1,At,B1); BAR;
    LDB(B0,1,0); SCHED; LDA(At,1,0); STAGE(SA(0,1),A,ldw,brow+G8_HALF,t+2);
    WAIT_L(8); BAR; WAIT_L(0); MMA(0,0,At,B0); BAR; SCHED;
    LDB(B1,1,1); STAGE(SB(1,0),Bt,ldx,bcol,t+3);
    BAR; WAIT_L(0); MMA(0,1,At,B1); BAR;
    LDA(At,1,1); STAGE(SA(1,0),A,ldw,brow,t+3);
    BAR; WAIT_L(0); MMA(1,0,At,B0); BAR; SCHED;
    STAGE(SB(1,1),Bt,ldx,bcol+G8_HALF,t+3);
    WAIT_V(6); BAR; MMA(1,1,At,B1); BAR;
  }
  { LDB(B0,0,0); LDA(At,0,0); STAGE(SA(1,1),A,ldw,brow+G8_HALF,nt-1);
    BAR; WAIT_L(0); MMA(0,0,At,B0); BAR;
    LDB(B1,0,1); BAR; WAIT_L(0); MMA(0,1,At,B1); BAR;
    LDA(At,0,1); WAIT_V(4); BAR; WAIT_L(0); MMA(1,0,At,B0); MMA(1,1,At,B1); BAR; }
  { LDB(B0,1,0); LDA(At,1,0); WAIT_V(2); BAR; WAIT_L(0); MMA(0,0,At,B0); BAR;
    LDB(B1,1,1); WAIT_V(0); BAR; WAIT_L(0); MMA(0,1,At,B1); BAR;
    LDA(At,1,1); BAR; WAIT_L(0); MMA(1,0,At,B0); MMA(1,1,At,B1); BAR; }
  if(wr==0)BAR;
  #undef SA
  #undef SB
  #undef STAGE
  #undef LDA
  #undef LDB
  #undef MMA
  #undef WAIT_V
  #undef WAIT_L
  #undef BAR
  #undef SCHED
}
DI void gemm8_out_tile(const Params& p, int l, const u16* W, int ldw, const u16* X, int ldx, int K, int brow, int bcol, char* smem, int mrows) {
  g8f4 acc[2][2][4][2];
  gemm8_mainloop(W, ldw, X, ldx, K, brow, bcol, smem, acc);
  const int tx = tid();
  const int wid = tx >> 6, lane = tx & 63, wr = wid >> 2, wc = wid & 3, fr = lane & 15, fq = lane >> 4;
  float* out = p.out;
#pragma unroll
  for (int bj = 0; bj < 2; ++bj)
#pragma unroll
    for (int nn = 0; nn < 2; ++nn) {
      const int row = bcol + bj * G8_HALF + wc * 32 + nn * 16 + fr;
      if (row >= mrows) continue;
      const float* res = (l == 0) ? (row < MP ? p.x_prompt + (size_t)row * 1024 : p.x_sample + (size_t)(row - MP) * 1024) : out + O_Y + (size_t)row * 1024;
      float* zo = out + O_Y + (size_t)row * 1024;
#pragma unroll
      for (int ai = 0; ai < 2; ++ai)
#pragma unroll
        for (int m = 0; m < 4; ++m) {
          const int n = brow + ai * G8_HALF + wr * 64 + m * 16 + fq * 4;
          const float4 x = *(const float4*)(res + n);
          const g8f4 v = acc[ai][bj][m][nn];
          *(float4*)(zo + n) = make_float4(ALPHA * x.x + v[0], ALPHA * x.y + v[1], ALPHA * x.z + v[2], ALPHA * x.w + v[3]);
        }
    }
}
DI void gemm8_h_tile(const Params& p, int l, const u16* W, int ldw, const u16* X, int ldx, int K, int brow, int bcol, char* smem) {
  g8f4 acc[2][2][4][2];
  gemm8_mainloop(W, ldw, X, ldx, K, brow, bcol, smem, acc);
  const int tx = tid();
  const int wid = tx >> 6, lane = tx & 63, wr = wid >> 2, wc = wid & 3, fr = lane & 15, fq = lane >> 4;
  char* ws = p.ws; float* out = p.out;
  const float2* tab = (const float2*)(ws + W_TAB);
#pragma unroll
  for (int bj = 0; bj < 2; ++bj)
#pragma unroll
    for (int nn = 0; nn < 2; ++nn) {
      const int row = bcol + bj * G8_HALF + wc * 32 + nn * 16 + fr;
      if (row >= MT) continue;
      const bool is_s = row >= MP;
      const int b = is_s ? ((row - MP) >> 4) : (row >> 12);
      const int tt = is_s ? ((row - MP) & 15) : (row & 4095);
#pragma unroll
      for (int ai = 0; ai < 2; ++ai) {
        const int nw = brow + ai * G8_HALF + wr * 64;
        if (nw == SEG_KR) {
          const int pos = is_s ? PAST + tt : tt;
          float* ko = is_s ? out + O_SKR + (size_t)l * MS * 64 + (size_t)(row - MP) * 64 : out + O_PKR + (size_t)l * MP * 64 + (size_t)row * 64;
          u16* kb = is_s ? (u16*)(ws + W_KRBS) + (size_t)(b * TAS + PAST + tt) * 64 : (u16*)(ws + W_KRBP) + (size_t)row * 64;
#pragma unroll
          for (int m = 0; m < 2; ++m) {
            const int c = m * 16 + fq * 4;
            const g8f4 x1 = acc[ai][bj][m][nn], x2 = acc[ai][bj][m + 2][nn];
            float y1[4], y2[4];
#pragma unroll
            for (int i = 0; i < 4; ++i) { const float2 cs = tab[pos * 32 + c + i]; y1[i] = x1[i] * cs.x - x2[i] * cs.y; y2[i] = x1[i] * cs.y + x2[i] * cs.x; }
            *(float4*)(ko + c) = make_float4(y1[0], y1[1], y1[2], y1[3]);
            *(float4*)(ko + 32 + c) = make_float4(y2[0], y2[1], y2[2], y2[3]);
            st4bf(kb + c, y1[0], y1[1], y1[2], y1[3]);
            st4bf(kb + 32 + c, y2[0], y2[1], y2[2], y2[3]);
          }
        } else if (nw >= SEG_FL) {
          if (fq == 0) {
            const g8f4 z4 = acc[ai][bj][0][nn];
            float lf[4];
#pragma unroll
            for (int i = 0; i < 4; ++i) { const float z = z4[i] + p.b_f[l * 4 + i]; lf[i] = fminf(z, 0.f) - log1pf(expf(-fabsf(z))); }
            float* fo = is_s ? out + O_SLOGF + (size_t)l * MS * 4 + (size_t)(row - MP) * 4 : out + O_PLOGF + (size_t)l * MP * 4 + (size_t)row * 4;
            *(float4*)fo = make_float4(lf[0], lf[1], lf[2], lf[3]);
          }
        } else {
#pragma unroll
          for (int m = 0; m < 4; ++m) {
            const int c = m * 16 + fq * 4;
            const g8f4 v = acc[ai][bj][m][nn];
            if (nw < SEG_CKV) {
              st4bf((u16*)(ws + W_CQ) + (size_t)row * 384 + nw + c, v[0], v[1], v[2], v[3]);
            } else if (nw < SEG_KR) {
              const int cc = nw - SEG_CKV + c;
              st4bf((u16*)(ws + W_CKV) + (size_t)row * 256 + cc, v[0], v[1], v[2], v[3]);
              float* lo = is_s ? out + O_SLAT + (size_t)l * MS * 256 + (size_t)(row - MP) * 256 : out + O_PLAT + (size_t)l * MP * 256 + (size_t)row * 256;
              *(float4*)(lo + cc) = make_float4(v[0], v[1], v[2], v[3]);
            } else if (nw < SEG_FQ || (nw >= SEG_GFOX && nw < SEG_MQ) || (nw >= SEG_GMEM && nw < SEG_FL)) {
              const int gc0 = nw < SEG_FQ ? nw - SEG_GMLA : (nw < SEG_MQ ? 512 + nw - SEG_GFOX : 768 + nw - SEG_GMEM);
              st4bf((u16*)(ws + W_GATE) + (size_t)row * GLD + gc0 + c, silu(v[0]), silu(v[1]), silu(v[2]), silu(v[3]));
            } else if (nw < SEG_FK) {
              st4bf((u16*)(ws + W_FQ) + (size_t)row * 256 + (nw - SEG_FQ) + c, v[0], v[1], v[2], v[3]);
            } else if (nw < SEG_FV) {
              const int cc = nw - SEG_FK + c;
              float* fo = (is_s ? out + O_SFK + (size_t)l * MS * 256 + (size_t)(row - MP) * 256 : out + O_PFK + (size_t)l * MP * 256 + (size_t)row * 256) + cc;
              u16* d = (is_s ? (u16*)(ws + W_FKBS) + (size_t)(b * TAS + PAST + tt) * 256 : (u16*)(ws + W_FKBP) + (size_t)row * 256) + cc;
              *(float4*)fo = make_float4(v[0], v[1], v[2], v[3]);
              st4bf(d, v[0], v[1], v[2], v[3]);
            } else if (nw < SEG_GFOX) {
              const int cc = nw - SEG_FV + c;
              float* fo = (is_s ? out + O_SFV + (size_t)l * MS * 256 + (size_t)(row - MP) * 256 : out + O_PFV + (size_t)l * MP * 256 + (size_t)row * 256) + cc;
              *(float4*)fo = make_float4(v[0], v[1], v[2], v[3]);
              u16* d = is_s ? (u16*)(ws + W_FVTS) + (size_t)(b * 256 + cc) * TAS + PAST + tt : (u16*)(ws + W_FVTP) + (size_t)(b * 256 + cc) * 4096 + tt;
              const size_t ldt = is_s ? TAS : 4096;
#pragma unroll
              for (int i = 0; i < 4; ++i) d[(size_t)i * ldt] = (u16)(pk2(v[i], 0.f) & 0xffffu);
            } else {
              st4bf((u16*)(ws + W_MQ) + (size_t)row * 256 + (nw - SEG_MQ) + c, v[0], v[1], v[2], v[3]);
            }
          }
        }
      }
    }
}

template <bool CACHE>
DI void gemm8_kv_tile(const Params& p, int l, const u16* W, const u16* X, int brow, int bcol, char* smem) {
  float* rs_lds = (float*)(smem + 2 * GEMM_BUF * 2);
  const int tx = tid();
  if constexpr (!CACHE) {
    const int row = tx >> 1, half = tx & 1;
    const u16* ap = X + (size_t)(bcol + row) * 256 + half * 128;
    float s = 0.f;
#pragma unroll
    for (int c = 0; c < 128; c += 8) {
      const u32x4 u = *(const u32x4*)(ap + c);
      s += bflo(u.x) * bflo(u.x) + bfhi(u.x) * bfhi(u.x) + bflo(u.y) * bflo(u.y) + bfhi(u.y) * bfhi(u.y);
      s += bflo(u.z) * bflo(u.z) + bfhi(u.z) * bfhi(u.z) + bflo(u.w) * bflo(u.w) + bfhi(u.w) * bfhi(u.w);
    }
    s += __shfl_xor(s, 1);
    if (half == 0) rs_lds[row] = rsqrtf(s * (1.f / 256.f) + EPS);
  }
  g8f4 acc[2][2][4][2];
  gemm8_mainloop(W, 256, X, 256, 256, brow, bcol, smem, acc);
  const int wid = tx >> 6, lane = tx & 63, wr = wid >> 2, wc = wid & 3, fr = lane & 15, fq = lane >> 4;
  char* ws = p.ws;
#pragma unroll
  for (int bj = 0; bj < 2; ++bj)
#pragma unroll
    for (int nn = 0; nn < 2; ++nn) {
      const int tl = bj * G8_HALF + wc * 32 + nn * 16 + fr;
      const int row = bcol + tl;
      float rs = 1.f; int b, tt; bool is_s;
      if constexpr (CACHE) { is_s = true; b = row >> 11; tt = row & 2047; }
      else {
        if (row >= MT) continue;
        rs = rs_lds[tl]; is_s = row >= MP;
        b = is_s ? ((row - MP) >> 4) : (row >> 12);
        tt = is_s ? PAST + ((row - MP) & 15) : (row & 4095);
      }
      const size_t T = is_s ? TAS : 4096;
      u16* knb = (u16*)(ws + (is_s ? W_KNS : W_KNP)); u16* vtb = (u16*)(ws + (is_s ? W_VTS : W_VTP));
#pragma unroll
      for (int ai = 0; ai < 2; ++ai) {
        const int nw = brow + ai * G8_HALF + wr * 64;
        const int head = nw >> 8, c0 = nw & 255;
        if (c0 < 128) {
          u16* d = knb + ((size_t)(b * 4 + head) * T + tt) * 128 + c0;
#pragma unroll
          for (int m = 0; m < 4; ++m) { const g8f4 v = acc[ai][bj][m][nn]; st4bf(d + m * 16 + fq * 4, v[0] * rs, v[1] * rs, v[2] * rs, v[3] * rs); }
        } else {
          u16* d = vtb + ((size_t)(b * 4 + head) * 128 + (c0 - 128)) * T + tt;
#pragma unroll
          for (int m = 0; m < 4; ++m) {
            const g8f4 v = acc[ai][bj][m][nn];
#pragma unroll
            for (int i = 0; i < 4; ++i) d[(size_t)(m * 16 + fq * 4 + i) * T] = (u16)(pk2(v[i] * rs, 0.f) & 0xffffu);
          }
        }
      }
    }
}

struct AttnItem {
  const u16* q; const u16* k1; const u16* k2; const u16* vt; const float* cum; u16* gate;
  int ldq, ldk1, ldv, qrow0, nq, qpos0, Tk, ntiles, dry;
};

template <int DK>
DI void attn_loadK(const AttnItem& a, int k0, unsigned offK, u32x4 (&rk)[3]) {
  if constexpr (DK == 192) {
    const char* b1 = (const char*)(a.k1 + (size_t)k0 * 128);
    const char* b2 = (const char*)(a.k2 + (size_t)k0 * 64);
#pragma unroll
    for (int i = 0; i < 2; ++i) rk[i] = *(const u32x4*)(b1 + (size_t)i * 8192 + offK);
    rk[2] = *(const u32x4*)(b2 + offK);
  } else {
    const char* b1 = (const char*)(a.k1 + (size_t)k0 * a.ldk1);
    rk[0] = *(const u32x4*)(b1 + offK);
  }
}
template <int DK>
DI void attn_storeK(u16* Ks, int t, u32x4 (&rk)[3]) {
  constexpr int KS = DK + 8;
  if constexpr (DK == 192) {
#pragma unroll
    for (int i = 0; i < 2; ++i) { const int c = t + 512 * i; const int key = c >> 4, kc = c & 15; *(u32x4*)(Ks + key * KS + kc * 8) = rk[i]; }
    { const int key = t >> 3, kc = t & 7; *(u32x4*)(Ks + key * KS + 128 + kc * 8) = rk[2]; }
  } else {
    const int key = t >> 3, kc = t & 7; *(u32x4*)(Ks + key * KS + kc * 8) = rk[0];
  }
}
template <int DV, int MODE>
DI void attn_loadV(const AttnItem& a, int k0, int t, unsigned offV, u32x4 (&rv)[2], float& rc) {
  const char* bv = (const char*)(a.vt + k0);
#pragma unroll
  for (int i = 0; i < DV / 64; ++i) rv[i] = *(const u32x4*)(bv + (size_t)i * 128 * a.ldv + offV);
  if constexpr (MODE == 1) { if (t < 64) rc = a.cum[k0 + t]; }
}
template <int DV, int MODE>
DI void attn_storeV(u16* Vs, float* Cs, int t, u32x4 (&rv)[2], float rc) {
  constexpr int VS = 68;
#pragma unroll
  for (int i = 0; i < DV / 64; ++i) {
    const int c = t + 512 * i; const int d = c >> 3, kc = c & 7;
    *(uint2*)(Vs + d * VS + kc * 8) = make_uint2(rv[i].x, rv[i].y);
    *(uint2*)(Vs + d * VS + kc * 8 + 4) = make_uint2(rv[i].z, rv[i].w);
  }
  if constexpr (MODE == 1) { if (t < 64) Cs[t] = rc * LOG2E; }
}

template <int DK, int DV, int MODE>
DI void attn_item(const AttnItem& a, float sc, char* smem) {
  constexpr int KS = DK + 8;
  constexpr int VS = 68;
  constexpr int STG = 64 * KS * 2 + DV * VS * 2 + 256;
  const int t = tid(), lane = t & 63, w = t >> 6, g = lane >> 5, r = lane & 31;
  const bool wave_active = (w * 32) < a.nq;
  const int ql = w * 32 + r;
  const int qlc = ql < a.nq ? ql : a.nq - 1;
  const int qrow = a.qrow0 + qlc;
  const int qpos = a.qpos0 + qlc;
  const int wq_lo = a.qpos0 + w * 32;
  const int wq_hi = a.qpos0 + ((w * 32 + 31) < a.nq ? (w * 32 + 31) : a.nq - 1);

  bf16x8 qf[DK / 16];
#pragma unroll
  for (int ks = 0; ks < DK / 16; ++ks) qf[ks] = *(const bf16x8*)(a.q + (size_t)qrow * a.ldq + ks * 16 + g * 8);
  f32x16 o[DV / 32];
#pragma unroll
  for (int db = 0; db < DV / 32; ++db)
#pragma unroll
    for (int i = 0; i < 16; ++i) o[db][i] = 0.f;
  float mrun = -1e30f, lsum = 0.f;
  float cq2 = 0.f;
  if constexpr (MODE == 1) cq2 = a.cum[qpos] * LOG2E;

  u32x4 rk[3], rv[2];
  float rc = 0.f;
  const unsigned offK = DK == 192 ? (unsigned)t * 16u : (unsigned)((t >> 3) * a.ldk1 * 2 + (t & 7) * 16);
  const unsigned offV = (unsigned)((t >> 3) * a.ldv * 2 + (t & 7) * 16);
  attn_loadK<DK>(a, 0, offK, rk);
  attn_loadV<DV, MODE>(a, 0, t, offV, rv, rc);
  for (int kt = -1; kt < a.ntiles; ++kt) {
    const int k0 = kt * 64;
    if (kt + 1 < a.ntiles) {
      char* sw = smem + ((kt + 1) & 1) * STG;
      attn_storeK<DK>((u16*)sw, t, rk);
      attn_storeV<DV, MODE>((u16*)(sw + 64 * KS * 2), (float*)(sw + 64 * KS * 2 + DV * VS * 2), t, rv, rc);
      if (kt + 2 < a.ntiles) { attn_loadK<DK>(a, k0 + 128, offK, rk); attn_loadV<DV, MODE>(a, k0 + 128, t, offV, rv, rc); }
    }
    __builtin_amdgcn_sched_barrier(0);
    const char* sr = smem + (kt & 1) * STG;
    const u16* Ks = (const u16*)sr; const u16* Vs = (const u16*)(sr + 64 * KS * 2); const float* Cs = (const float*)(sr + 64 * KS * 2 + DV * VS * 2);
    bool do_tile = wave_active && kt >= 0;
    if constexpr (MODE == 0) do_tile = do_tile && (kt <= (wq_lo >> 6));
    if constexpr (MODE == 1) do_tile = do_tile && (k0 <= wq_hi);
    f32x16 s[2];
    if (do_tile) {
#pragma unroll
      for (int kb = 0; kb < 2; ++kb) {
#pragma unroll
        for (int i = 0; i < 16; ++i) s[kb][i] = 0.f;
#pragma unroll
        for (int ks = 0; ks < DK / 16; ++ks) {
          const bf16x8 kf = *(const bf16x8*)(Ks + (kb * 32 + r) * KS + ks * 16 + g * 8);
          s[kb] = MFMA(kf, qf[ks], s[kb]);
          if ((ks & 3) == 3) __builtin_amdgcn_sched_barrier(0);
        }
      }
    }
    if (do_tile) {
      bool need_mask = false;
      if constexpr (MODE == 0) need_mask = (k0 + 64 > a.Tk);
      if constexpr (MODE == 1) need_mask = (k0 + 63 > wq_lo);
      float tmax = -1e30f;
      if constexpr (MODE == 1) {
#pragma unroll
        for (int kb = 0; kb < 2; ++kb)
#pragma unroll
          for (int j = 0; j < 4; ++j) {
            const float4 cb = *(const float4*)(Cs + kb * 32 + 8 * j + 4 * g);
            s[kb][4 * j + 0] = fmaf(s[kb][4 * j + 0], sc, cq2 - cb.x);
            s[kb][4 * j + 1] = fmaf(s[kb][4 * j + 1], sc, cq2 - cb.y);
            s[kb][4 * j + 2] = fmaf(s[kb][4 * j + 2], sc, cq2 - cb.z);
            s[kb][4 * j + 3] = fmaf(s[kb][4 * j + 3], sc, cq2 - cb.w);
          }
      }
      if (need_mask) {
#pragma unroll
        for (int kb = 0; kb < 2; ++kb)
#pragma unroll
          for (int j = 0; j < 4; ++j)
#pragma unroll
            for (int i = 0; i < 4; ++i) {
              const int key = k0 + kb * 32 + 8 * j + 4 * g + i;
              bool ok = true;
              if constexpr (MODE == 0) ok = key < a.Tk;
              if constexpr (MODE == 1) ok = key <= qpos;
              s[kb][4 * j + i] = ok ? s[kb][4 * j + i] : -1e30f;
            }
      }
#pragma unroll
      for (int kb = 0; kb < 2; ++kb)
#pragma unroll
        for (int i = 0; i < 16; ++i) tmax = fmaxf(tmax, s[kb][i]);
      if constexpr (MODE != 1) tmax *= sc;
      tmax = half_max(tmax);
      const float mnew = fmaxf(mrun, tmax);
      const float alpha = ex2(mrun - mnew);
      const bool changed = mnew != mrun;
      mrun = mnew;
      typedef float f32x2 __attribute__((ext_vector_type(2)));
      f32x2 ps2 = {0.f, 0.f};
      const f32x2 sc2 = {sc, sc}, nm2 = {-mnew, -mnew};
#pragma unroll
      for (int kb = 0; kb < 2; ++kb)
#pragma unroll
        for (int i = 0; i < 16; i += 2) {
          f32x2 a2 = {s[kb][i], s[kb][i + 1]};
          if constexpr (MODE == 1) a2 = a2 + nm2; else a2 = __builtin_elementwise_fma(a2, sc2, nm2);
          f32x2 p2 = {ex2(a2.x), ex2(a2.y)};
          s[kb][i] = p2.x; s[kb][i + 1] = p2.y;
          ps2 = ps2 + p2;
        }
      const float psum = ps2.x + ps2.y;
      lsum = lsum * alpha + psum;
      if (__builtin_amdgcn_ballot_w64(changed) != 0ull) {
#pragma unroll
        for (int db = 0; db < DV / 32; ++db)
#pragma unroll
          for (int i = 0; i < 16; ++i) o[db][i] *= alpha;
      }
#pragma unroll
      for (int kb = 0; kb < 2; ++kb)
#pragma unroll
        for (int u = 0; u < 2; ++u) {
          const unsigned p0 = pk2(s[kb][8 * u + 0], s[kb][8 * u + 1]), p1 = pk2(s[kb][8 * u + 2], s[kb][8 * u + 3]);
          const unsigned p2 = pk2(s[kb][8 * u + 4], s[kb][8 * u + 5]), p3 = pk2(s[kb][8 * u + 6], s[kb][8 * u + 7]);
          const bf16x8 pf = __builtin_bit_cast(bf16x8, make_uint4(p0, p1, p2, p3));
#pragma unroll
          for (int db = 0; db < DV / 32; ++db) {
            const u16* vp = Vs + (db * 32 + r) * VS + kb * 32 + 16 * u + 4 * g;
            const s16x4 lo = *(const s16x4*)vp;
            const s16x4 hi = *(const s16x4*)(vp + 8);
            const bf16x8 vf = __builtin_shufflevector(lo, hi, 0, 1, 2, 3, 4, 5, 6, 7);
            o[db] = MFMA(vf, pf, o[db]);
          }
          __builtin_amdgcn_sched_barrier(0);
        }
    }
    __syncthreads();
  }
  if (wave_active) {
    const float ltot = half_sum(lsum);
    const float inv = 1.f / ltot;
    if (ql < a.nq && !a.dry) {
      u16* gp = a.gate + (size_t)qrow * GLD;
#pragma unroll
      for (int db = 0; db < DV / 32; ++db)
#pragma unroll
        for (int j = 0; j < 4; ++j) {
          const int d = db * 32 + 8 * j + 4 * g;
          const uint2 gv = *(const uint2*)(gp + d);
          st4bf(gp + d, o[db][4 * j] * inv * bflo(gv.x), o[db][4 * j + 1] * inv * bfhi(gv.x),
                o[db][4 * j + 2] * inv * bflo(gv.y), o[db][4 * j + 3] * inv * bfhi(gv.y));
        }
    }
  }
}

DI float wave_sum(float v) {
#pragma unroll
  for (int o = 32; o > 0; o >>= 1) v += __shfl_xor(v, o);
  return v;
}
DI void lat_rows(const Params& p, int l, int row0, int nrows) {
  const int t_ = tid(); const int lane = t_ & 63, w = t_ >> 6;
  const f32x4 gv = *(const f32x4*)(p.kvn_g + l * 256 + lane * 4);
  f32x4 v[8];
#pragma unroll
  for (int k = 0; k < 8; ++k) {
    const int row = row0 + w + 8 * k;
    const float* d = row < MP ? p.out + O_PLAT + (size_t)l * MP * 256 + (size_t)row * 256 : p.out + O_SLAT + (size_t)l * MS * 256 + (size_t)(row - MP) * 256;
    v[k] = *(const f32x4*)(d + lane * 4);
  }
#pragma unroll
  for (int k = 0; k < 8; ++k) {
    const int row = row0 + w + 8 * k;
    float* d = row < MP ? p.out + O_PLAT + (size_t)l * MP * 256 + (size_t)row * 256 : p.out + O_SLAT + (size_t)l * MS * 256 + (size_t)(row - MP) * 256;
    const float ss = wave_sum(v[k].x * v[k].x + v[k].y * v[k].y + v[k].z * v[k].z + v[k].w * v[k].w);
    const float rs = rsqrtf(ss * (1.f / 256.f) + EPS);
    *(f32x4*)(d + lane * 4) = v[k] * rs * gv;
  }
}
DI void ln_rows(const Params& p, int l, int row0, int nrows) {
  const int t_ = tid(); const int lane = t_ & 63, w = t_ >> 6;
  u16* Xb = (u16*)(p.ws + W_XB);
  f32x4 v[4][4], gg[4], bb[4];
#pragma unroll
  for (int k = 0; k < 4; ++k)
#pragma unroll
    for (int i = 0; i < 4; ++i) v[k][i] = *(const f32x4*)(p.out + O_Y + (size_t)(row0 + w + 8 * k) * 1024 + i * 256 + lane * 4);
#pragma unroll
  for (int i = 0; i < 4; ++i) { gg[i] = *(const f32x4*)(p.ln_g + l * 1024 + i * 256 + lane * 4); bb[i] = *(const f32x4*)(p.ln_b + l * 1024 + i * 256 + lane * 4); }
#pragma unroll
  for (int k = 0; k < 4; ++k) {
    const int row = row0 + w + 8 * k;
    float* d = p.out + O_Y + (size_t)row * 1024;
    float s = 0.f;
#pragma unroll
    for (int i = 0; i < 4; ++i) s += v[k][i].x + v[k][i].y + v[k][i].z + v[k][i].w;
    const float mu = wave_sum(s) * (1.f / 1024.f);
    float q = 0.f;
#pragma unroll
    for (int i = 0; i < 4; ++i) { v[k][i] = v[k][i] - mu; q += v[k][i].x * v[k][i].x + v[k][i].y * v[k][i].y + v[k][i].z * v[k][i].z + v[k][i].w * v[k][i].w; }
    const float rstd = rsqrtf(wave_sum(q) * (1.f / 1024.f) + EPS);
#pragma unroll
    for (int i = 0; i < 4; ++i) {
      const f32x4 y = v[k][i] * rstd * gg[i] + bb[i];
      *(f32x4*)(d + i * 256 + lane * 4) = y;
      if (l == 0) st4bf(Xb + (size_t)row * 1024 + i * 256 + lane * 4, y.x, y.y, y.z, y.w);
    }
  }
}
DI void cumsum_item(const Params& p, int l, int idx, char* smem) {
  float* sw = (float*)smem;
  const int t = tid(), lane = t & 63, w = t >> 6;
  const bool samp = idx >= 16;
  const int bh = samp ? idx - 16 : idx, b = bh >> 2, h = bh & 3;
  const int t0 = t * 8;
  float v[8];
#pragma unroll
  for (int j = 0; j < 8; ++j) {
    const int tt = t0 + j;
    float x = 0.f;
    if (!samp) x = p.out[O_PLOGF + (size_t)l * MP * 4 + (size_t)(b * 4096 + tt) * 4 + h];
    else if (tt < PAST) x = p.c_logf[(size_t)l * BS * PAST * 4 + (size_t)(b * PAST + tt) * 4 + h];
    else if (tt < TKS) x = p.out[O_SLOGF + (size_t)l * MS * 4 + (size_t)(b * 16 + tt - PAST) * 4 + h];
    v[j] = x;
  }
#pragma unroll
  for (int j = 1; j < 8; ++j) v[j] += v[j - 1];
  float tot = v[7], inc = tot;
#pragma unroll
  for (int o = 1; o < 64; o <<= 1) { const float n = __shfl_up(inc, o); if (lane >= o) inc += n; }
  if (lane == 63) sw[w] = inc;
  __syncthreads();
  float base = inc - tot;
  for (int i = 0; i < w; ++i) base += sw[i];
  float* dst = samp ? (float*)(p.ws + W_CUMS) + (size_t)bh * TAS : (float*)(p.ws + W_CUMP) + (size_t)bh * 4096;
  const int tmax = samp ? TAS : 4096;
  if (t0 < tmax) {
#pragma unroll
    for (int j = 0; j < 8; j += 4) *(float4*)(dst + t0 + j) = make_float4(base + v[j], base + v[j + 1], base + v[j + 2], base + v[j + 3]);
  }
}

DI void phase_p1(const Params& p, int l, unsigned* ctr, int* s_item, char* smem) {
  phase_cacheconv(p, l);
  const int NT = N1 / 256;
  const u16* Xb = (const u16*)(p.ws + W_XB);
  const u16* Wt = (const u16*)(p.ws + W_WIN) + (size_t)l * N1 * 1024;
  const int n_mem = (l == 0) ? 2 : 0;
  FOR_QUEUES(q, j, q_mtiles(q, 65) * NT + n_mem)
    const int kq = q_mtiles(q, 65), n_h = kq * NT;
    if (j < n_h) {
      const int nt = j / kq, ml = j - nt * kq;
      const int mt = q + 8 * ml;
      gemm8_h_tile(p, l, Wt, 1024, Xb, 1024, 1024, nt * 256, mt * 256, smem);
    } else {
      const int jj = q * 2 + (j - n_h), l2 = jj >> 3, mt = (jj >> 1) & 3, nt = jj & 1;
      gemm_tile<false, false, EPI_MEMKV>(p, l2, p.ws + W_MEMB, 1024, (const u16*)(p.ws + W_WMKV) + (size_t)l2 * 512 * 1024, 1024, 1024, mt * 256, nt * 256, smem, 1024);
    }
  END_QUEUES
}
DI void phase_p3(const Params& p, int l, unsigned* ctr, int* s_item, char* smem, bool skip_lat = false) {
  FOR_QUEUES(q, j, 6 + 8 * 4 + q_mtiles(q, 65) * 7 + (258 - q + 7) / 8)
    const int kq = q_mtiles(q, 65);
    const int e0 = 6, e1 = e0 + 8 * 4, e2 = e1 + kq * 4, e3 = e2 + kq * 3;
    if (j < e0) cumsum_item(p, l, q * 6 + j, smem);
    else if (j < e1) {
      const int jj = j - e0, mt = q + 8 * (jj >> 2), nt = jj & 3;
      gemm8_kv_tile<true>(p, l, (const u16*)(p.ws + W_WUKV) + (size_t)l * 1024 * 256, (const u16*)(p.ws + W_LATC), nt * 256, mt * 256, smem);
    } else if (j < e2) {
      const int jj = j - e1, mt = q + 8 * (jj >> 2), nt = jj & 3;
      gemm8_kv_tile<false>(p, l, (const u16*)(p.ws + W_WUKVF) + (size_t)l * 1024 * 256, (const u16*)(p.ws + W_CKV), nt * 256, mt * 256, smem);
    } else if (j < e3) {
      const int jj = j - e2, mt = q + 8 * (jj / 3), nt = jj % 3;
      gemm_tile<false, true, EPI_Q>(p, l, p.ws + W_CQ, 384, (const u16*)(p.ws + W_WUQ) + (size_t)l * 768 * 384, 384, 384, mt * 256, nt * 256, smem, MT);
    } else if (!skip_lat) lat_rows(p, l, (q + 8 * (j - e3)) * 64, 64);
  END_QUEUES
}
DI void phase_p4(const Params& p, int l, unsigned* ctr, int* s_item, char* smem, int dry = 0) {
  char* ws = p.ws;
  const float sc_mla = 0.07216878364870322f * LOG2E, sc_64 = 0.125f * LOG2E;
  unsigned* barw = (unsigned*)(p.ws + W_BAR);
  FOR_QUEUES(q, j, 108 + ((q < 4 && !dry) ? 1 : 0))
    if (j >= 108) {
      if (threadIdx.x == 0) {
        XB_SPIN(xb_ld(barw + XB_SCNT(l)) < 96u, barw);
        __builtin_amdgcn_fence(__ATOMIC_ACQUIRE, "agent");
        asm volatile("s_waitcnt vmcnt(0)" ::: "memory");
      }
      __syncthreads();
      gemm8_out_tile(p, l, (const u16*)(ws + W_WOUT) + (size_t)l * 1024 * GLD, GLD, (const u16*)(ws + W_GATE), GLD, 1024, q * 256, 64 * 256, smem, MT);
    } else {
    int it, b, h, qb = 0;
    if (j < 12) { it = j < 4 ? 0 : (j < 8 ? 32 : 1600); b = q; h = j & 3; }
    else if (j < 76) { const int jj = j - 12; it = jj < 32 ? 64 : 576; const int k = jj & 31; qb = 15 - (k >> 1); const int bh = q + 8 * (k & 1); b = bh >> 2; h = bh & 3; }
    else { const int k = j - 76; it = 1088; qb = k >> 1; const int bh = q + 8 * (k & 1); b = bh >> 2; h = bh & 3; }
    AttnItem a;
    a.k2 = nullptr; a.cum = nullptr; a.dry = dry;
    if (it < 32 || (it >= 64 && it < 576)) {
      const bool samp = it < 32;
      const int T = samp ? TAS : 4096;
      a.q = (const u16*)(ws + W_XB) + h * 192; a.ldq = 768;
      a.k1 = (const u16*)(ws + (samp ? W_KNS : W_KNP)) + (size_t)(b * 4 + h) * T * 128; a.ldk1 = 128;
      a.k2 = (const u16*)(ws + (samp ? W_KRBS : W_KRBP)) + (size_t)b * T * 64;
      a.vt = (const u16*)(ws + (samp ? W_VTS : W_VTP)) + (size_t)(b * 4 + h) * 128 * T; a.ldv = T;
      a.gate = (u16*)(ws + W_GATE) + h * 128;
      if (samp) { a.qrow0 = MP + b * 16; a.nq = 16; a.qpos0 = PAST; a.Tk = TKS; a.ntiles = 33; }
      else { a.qrow0 = b * 4096 + qb * 256; a.nq = 256; a.qpos0 = qb * 256; a.Tk = 4096; a.ntiles = 4 * qb + 4; }
      attn_item<192, 128, 0>(a, sc_mla, smem);
    } else if (it < 64 || it < 1088) {
      const bool samp = it < 64;
      const int T = samp ? TAS : 4096;
      a.q = (const u16*)(ws + W_FQ) + h * 64; a.ldq = 256;
      a.k1 = (const u16*)(ws + (samp ? W_FKBS : W_FKBP)) + (size_t)b * T * 256 + h * 64; a.ldk1 = 256;
      a.vt = (const u16*)(ws + (samp ? W_FVTS : W_FVTP)) + (size_t)(b * 4 + h) * 64 * T; a.ldv = T;
      a.cum = (const float*)(ws + (samp ? W_CUMS : W_CUMP)) + (size_t)(b * 4 + h) * T;
      a.gate = (u16*)(ws + W_GATE) + 512 + h * 64;
      if (samp) { a.qrow0 = MP + b * 16; a.nq = 16; a.qpos0 = PAST; a.Tk = TKS; a.ntiles = 33; }
      else { a.qrow0 = b * 4096 + qb * 256; a.nq = 256; a.qpos0 = qb * 256; a.Tk = 4096; a.ntiles = 4 * qb + 4; }
      attn_item<64, 64, 1>(a, sc_64, smem);
    } else {
      const bool samp = it >= 1600;
      a.q = (const u16*)(ws + W_MQ) + h * 64; a.ldq = 256;
      a.k1 = (samp ? (const u16*)(ws + W_MEMKS) : (const u16*)(ws + W_MEMKP) + (size_t)l * 1024 * 256) + (size_t)b * NMEM * 256 + h * 64; a.ldk1 = 256;
      a.vt = (samp ? (const u16*)(ws + W_MEMVTS) : (const u16*)(ws + W_MEMVTP) + (size_t)l * 1024 * 256) + (size_t)(b * 4 + h) * 64 * NMEM; a.ldv = NMEM;
      a.gate = (u16*)(ws + W_GATE) + 768 + h * 64;
      a.Tk = NMEM; a.ntiles = 4; a.qpos0 = 0;
      if (samp) { a.qrow0 = MP + b * 16; a.nq = 16; } else { a.qrow0 = b * 4096 + qb * 256; a.nq = 256; }
      attn_item<64, 64, 2>(a, sc_64, smem);
    }
    if ((it == 0 || it == 32 || it == 1600) && !dry) {
      asm volatile("s_waitcnt vmcnt(0)" ::: "memory");
      __syncthreads();
      if (threadIdx.x == 0) {
        __builtin_amdgcn_fence(__ATOMIC_RELEASE, "agent");
        asm volatile("s_waitcnt vmcnt(0)" ::: "memory");
        (void)xb_add(barw + XB_SCNT(l), 1u);
      }
    }
    }
  END_QUEUES
}
DI void phase_p5(const Params& p, int l, unsigned* ctr, int* s_item, char* smem) {
  FOR_QUEUES(q, j, 8 * 4)
    const int kq = 8;
    const int nt = j / kq, ml = j - nt * kq;
    const int mt = q + 8 * ml;
    gemm8_out_tile(p, l, (const u16*)(p.ws + W_WOUT) + (size_t)l * 1024 * GLD, GLD, (const u16*)(p.ws + W_GATE), GLD, 1024, nt * 256, mt * 256, smem, MT);
  END_QUEUES
}
DI void phase_p6(const Params& p, int l, unsigned* ctr, int* s_item) {
  FOR_QUEUES(q, j, 64)
    const int it = q + 8 * j;
    ln_rows(p, l, it * 32, 32);
    if (it < 4) ln_rows(p, l, MP + it * 32, 32);
  END_QUEUES
}

__global__ void __launch_bounds__(512, 2) mega_kernel(Params p, int ph_begin, int ph_end) {
  __shared__ __attribute__((aligned(16))) char smem_all[SMEM_BYTES + 32];
  char* smem = smem_all;
  uint4& xb_words = *(uint4*)(smem_all + SMEM_BYTES);
  int& s_item = *(int*)(smem_all + SMEM_BYTES + 16);
  unsigned* bar = (unsigned*)(p.ws + W_BAR);
  if (threadIdx.x == 0) xb_words = make_uint4(0u, 0u, 0u, 0u);
  __syncthreads();
  XcdBarrier xb;
  const bool multi = (ph_end - ph_begin) > 1;
  if (multi) xb = xcd_barrier_post(bar, (volatile LAS unsigned*)&xb_words);
  for (int ph = ph_begin; ph < ph_end; ++ph) {
    unsigned* ctr = bar + XB_CTR(ph);
    if (ph == 0) phase_prep(p);
    else {
      const int l = (ph - 1) / 5, k = (ph - 1) % 5;
      if (k == 0) phase_p1(p, l, ctr, &s_item, smem);
      else if (k == 1) phase_p3(p, l, ctr, &s_item, smem);
      else if (k == 2) phase_p4(p, l, ctr, &s_item, smem);
      else if (k == 3) phase_p5(p, l, ctr, &s_item, smem);
      else phase_p6(p, l, ctr, &s_item);
    }
#if PROBE_KIND >= 0
    if (ph > 0 && (ph - 1) % 5 == PROBE_KIND && multi) {
      xcd_barrier(xb);
      const int l = (ph - 1) / 5;
      unsigned* ctr2 = bar + XB_CTR(ph + 16);
      if (PROBE_KIND == 0) phase_p1(p, l, ctr2, &s_item, smem);
      else if (PROBE_KIND == 1) phase_p3(p, l, ctr2, &s_item, smem, true);
      else if (PROBE_KIND == 2) phase_p4(p, l, ctr2, &s_item, smem, p.pad + 1);
      else if (PROBE_KIND == 3 && l == 0) phase_p5(p, l, ctr2, &s_item, smem);
    }
#endif
    if (ph + 1 < ph_end) {
      if (p.use_cg) cg::this_grid().sync();
      else xcd_barrier(xb);
    }
  }
}

extern "C" void kernel_launch(void* const* d_in, const int* in_sizes, int n_in, void* d_out, int out_size, void* d_ws,
                              size_t ws_size, hipStream_t stream) {
  Params p{};
  p.x_prompt = (const float*)d_in[0]; p.x_sample = (const float*)d_in[1];
  p.c_lat = (const float*)d_in[2]; p.c_kr = (const float*)d_in[3]; p.c_fk = (const float*)d_in[4]; p.c_fv = (const float*)d_in[5];
  p.c_logf = (const float*)d_in[6]; p.c_mk = (const float*)d_in[7]; p.c_mv = (const float*)d_in[8];
  p.mem_prompt = (const float*)d_in[9]; p.w_in = (const float*)d_in[10]; p.b_f = (const float*)d_in[11];
  p.qn_g = (const float*)d_in[12]; p.kvn_g = (const float*)d_in[13]; p.w_uq = (const float*)d_in[14]; p.w_ukv = (const float*)d_in[15];
  p.w_memkv = (const float*)d_in[16]; p.w_out = (const float*)d_in[17]; p.ln_g = (const float*)d_in[18]; p.ln_b = (const float*)d_in[19];
  p.out = (float*)d_out; p.ws = (char*)d_ws; p.use_cg = 0; p.pad = 0;
  static int grid_blocks = 0;
  if (!grid_blocks) {
    int dev = 0, cus = 0, per_cu = 0;
    hipGetDevice(&dev);
    hipDeviceGetAttribute(&cus, hipDeviceAttributeMultiprocessorCount, dev);
    hipOccupancyMaxActiveBlocksPerMultiprocessor(&per_cu, mega_kernel, NTH, 0);
    if (per_cu > 1) per_cu = 1;
    if (per_cu < 1) per_cu = 1;
    grid_blocks = cus * per_cu;
  }
  hipMemsetAsync((char*)d_ws + W_BAR, 0, BAR_BYTES, stream);
#if MK_LAUNCHES == 1
  int b = 0, e = NPH;
  void* args[] = {&p, &b, &e};
  hipError_t err = hipLaunchCooperativeKernel((const void*)mega_kernel, dim3(grid_blocks), dim3(NTH), args, 0, stream);
  if (err != hipSuccess) fprintf(stderr, "cooperative launch failed: %s (grid %d)\n", hipGetErrorString(err), grid_blocks);
#else
  for (int ph = 0; ph < NPH; ++ph) mega_kernel<<<dim3(grid_blocks), dim3(NTH), 0, stream>>>(p, ph, ph + 1);
#endif
}
```

```cpp
#include <hip/hip_runtime.h>
#include <hip/hip_cooperative_groups.h>
#include <cstdio>
#include <cstdint>
namespace cg = cooperative_groups;

#ifndef PROBE_KIND
#define PROBE_KIND -1
#endif
#ifndef MK_LAUNCHES
#define MK_LAUNCHES 1
#endif

#define DI __device__ __forceinline__
typedef unsigned short u16;
typedef __attribute__((ext_vector_type(8))) short bf16x8;
typedef __attribute__((ext_vector_type(4))) short s16x4;
typedef __attribute__((ext_vector_type(16))) float f32x16;
typedef __attribute__((ext_vector_type(2))) __bf16 bf2_t;
typedef unsigned u32x4 __attribute__((ext_vector_type(4)));
typedef float f32x4 __attribute__((ext_vector_type(4)));
#define MFMA(a, b, c) __builtin_amdgcn_mfma_f32_32x32x16_bf16((a), (b), (c), 0, 0, 0)

constexpr int D = 1024, BP = 4, TP = 4096, BS = 8, TS = 16, PAST = 2048;
constexpr int MP = BP * TP;
constexpr int MS = BS * TS;
constexpr int MT = MP + MS;
constexpr int TKS = PAST + TS;
constexpr int TAS = 2112;
constexpr int DIN = 2756, N1 = 2816;
constexpr int NMEM = 256;
constexpr float LOG2E = 1.4426950408889634f;
constexpr float EPS = 1e-6f;
constexpr float ALPHA = 1.4142135623730951f;

constexpr int SEG_CQ = 0, SEG_CKV = 384, SEG_KR = 640, SEG_GMLA = 704, SEG_FQ = 1216, SEG_FK = 1472, SEG_FV = 1728,
              SEG_GFOX = 1984, SEG_MQ = 2240, SEG_GMEM = 2496, SEG_FL = 2752;

constexpr size_t O_Y = 0;
constexpr size_t O_PLAT = (size_t)MT * D;
constexpr size_t O_PKR = O_PLAT + (size_t)2 * MP * 256;
constexpr size_t O_PFK = O_PKR + (size_t)2 * MP * 64;
constexpr size_t O_PFV = O_PFK + (size_t)2 * MP * 256;
constexpr size_t O_PLOGF = O_PFV + (size_t)2 * MP * 256;
constexpr size_t O_PMK = O_PLOGF + (size_t)2 * MP * 4;
constexpr size_t O_PMV = O_PMK + (size_t)2 * BP * NMEM * 256;
constexpr size_t O_SLAT = O_PMV + (size_t)2 * BP * NMEM * 256;
constexpr size_t O_SKR = O_SLAT + (size_t)2 * MS * 256;
constexpr size_t O_SFK = O_SKR + (size_t)2 * MS * 64;
constexpr size_t O_SFV = O_SFK + (size_t)2 * MS * 256;
constexpr size_t O_SLOGF = O_SFV + (size_t)2 * MS * 256;
constexpr size_t O_TOTAL = O_SLOGF + (size_t)2 * MS * 4;
static_assert(O_TOTAL == 45564928, "output size");

constexpr size_t al256(size_t x) { return (x + 255) & ~(size_t)255; }
constexpr size_t BAR_BYTES = 32768;
constexpr size_t W_BAR = 0;
constexpr size_t W_TAB = W_BAR + BAR_BYTES;
constexpr size_t W_XB = W_TAB + (size_t)4096 * 32 * 8;
constexpr size_t W_GATE = W_XB + (size_t)MT * 1024 * 2;
constexpr size_t W_CQ = W_GATE + (size_t)(MT + 128) * 1088 * 2;
constexpr size_t W_CKV = W_CQ + (size_t)MT * 384 * 2;
constexpr size_t W_FQ = W_CKV + (size_t)MT * 256 * 2;
constexpr size_t W_MQ = W_FQ + (size_t)MT * 256 * 2;
constexpr size_t W_FKBP = W_MQ + (size_t)MT * 256 * 2;
constexpr size_t W_FVTP = W_FKBP + (size_t)MP * 256 * 2;
constexpr size_t W_KRBP = W_FVTP + (size_t)MP * 256 * 2;
constexpr size_t W_KNP = W_KRBP + (size_t)MP * 64 * 2;
constexpr size_t W_VTP = W_KNP + (size_t)16 * 4096 * 128 * 2;
constexpr size_t W_FKBS = W_VTP + (size_t)16 * 4096 * 128 * 2;
constexpr size_t W_FVTS = W_FKBS + (size_t)BS * TAS * 256 * 2;
constexpr size_t W_KRBS = W_FVTS + (size_t)BS * TAS * 256 * 2;
constexpr size_t W_KNS = W_KRBS + (size_t)BS * TAS * 64 * 2;
constexpr size_t W_VTS = W_KNS + (size_t)32 * TAS * 128 * 2;
constexpr size_t W_MEMKP = W_VTS + (size_t)32 * TAS * 128 * 2;
constexpr size_t W_MEMVTP = W_MEMKP + (size_t)2 * 1024 * 256 * 2;
constexpr size_t W_MEMKS = W_MEMVTP + (size_t)2 * 1024 * 256 * 2;
constexpr size_t W_MEMVTS = W_MEMKS + (size_t)2048 * 256 * 2;
constexpr size_t W_MEMB = W_MEMVTS + (size_t)2048 * 256 * 2;
constexpr size_t W_WIN = W_MEMB + (size_t)1024 * 1024 * 2;
constexpr size_t W_WUQ = W_WIN + (size_t)2 * N1 * 1024 * 2;
constexpr size_t W_WUKV = W_WUQ + (size_t)2 * 768 * 384 * 2;
constexpr size_t W_WUKVF = W_WUKV + (size_t)2 * 1024 * 256 * 2;
constexpr size_t W_WMKV = W_WUKVF + (size_t)2 * 1024 * 256 * 2;
constexpr size_t W_WOUT = W_WMKV + (size_t)2 * 512 * 1024 * 2;
constexpr size_t W_CUMP = W_WOUT + (size_t)2 * 1024 * 1088 * 2;
constexpr size_t W_CUMS = W_CUMP + (size_t)16 * 4096 * 4;
constexpr size_t W_LATC = W_CUMS + (size_t)32 * TAS * 4;
constexpr size_t W_END = W_LATC + (size_t)BS * PAST * 256 * 2;
static_assert(W_END <= (size_t)256 * 1024 * 1024, "workspace too large");

constexpr int GLD = 1088;
constexpr int NPH = 11;
constexpr int NTH = 512;

struct Params {
  const float* x_prompt; const float* x_sample;
  const float* c_lat; const float* c_kr; const float* c_fk; const float* c_fv; const float* c_logf;
  const float* c_mk; const float* c_mv;
  const float* mem_prompt; const float* w_in; const float* b_f; const float* qn_g; const float* kvn_g;
  const float* w_uq; const float* w_ukv; const float* w_memkv; const float* w_out; const float* ln_g; const float* ln_b;
  float* out; char* ws;
  int use_cg; int pad;
};

DI unsigned pk2(float a, float b) { bf2_t v; v[0] = (__bf16)a; v[1] = (__bf16)b; return __builtin_bit_cast(unsigned, v); }
DI void st4bf(u16* p, float a, float b, float c, float d) { *(uint2*)p = make_uint2(pk2(a, b), pk2(c, d)); }
DI float bflo(unsigned u) { return __uint_as_float(u << 16); }
DI float bfhi(unsigned u) { return __uint_as_float(u & 0xffff0000u); }
DI float silu(float x) { return x / (1.f + __expf(-x)); }
DI float ex2(float x) { return __builtin_amdgcn_exp2f(x); }
DI float half_max(float v) { const auto r = __builtin_amdgcn_permlane32_swap(__float_as_uint(v), __float_as_uint(v), false, false); return fmaxf(__uint_as_float(r[0]), __uint_as_float(r[1])); }
DI float half_sum(float v) { const auto r = __builtin_amdgcn_permlane32_swap(__float_as_uint(v), __float_as_uint(v), false, false); return __uint_as_float(r[0]) + __uint_as_float(r[1]); }

DI int tid() { int t = threadIdx.x; asm volatile("" : "+v"(t)); return t; }

#define XB_TMO      128
#define XB_XCNT(j)  (256  + 64 * (j))
#define XB_XSUB(j)  (1280 + 64 * (j))
#define XB_XGEN(j)  (2304 + 64 * (j))
#define XB_TOP      3328
#define XB_TOPGEN   3392
#define XB_CTR(ph)  (4096 + 128 * (ph))
#define XB_SCNT(l)  (7680 + 64 * (l))
#define XB_SPIN_CAP (1u << 22)
#define LAS __attribute__((address_space(3)))
DI unsigned xb_ld(unsigned* p) { return __hip_atomic_load(p, __ATOMIC_RELAXED, __HIP_MEMORY_SCOPE_AGENT); }
DI unsigned xb_add(unsigned* p, unsigned v) { return __hip_atomic_fetch_add(p, v, __ATOMIC_RELAXED, __HIP_MEMORY_SCOPE_AGENT); }
DI unsigned xb_xcc_id() { return (unsigned)__builtin_amdgcn_s_getreg((3 << 11) | 20) & 0xFu; }
#define XB_SPIN(cond, bar) do { unsigned _sp = 0; while (cond) { __builtin_amdgcn_s_sleep(1); \
    if ((++_sp & 255u) == 0u) { if (xb_ld(&(bar)[XB_TMO])) break; if (_sp > XB_SPIN_CAP) { atomicAdd(&(bar)[XB_TMO], 1u); break; } } } } while (0)
struct XcdBarrier { unsigned* bar; unsigned x; volatile LAS unsigned* st; };
DI XcdBarrier xcd_barrier_post(unsigned* bar, volatile LAS unsigned* st) {
  XcdBarrier b; b.bar = bar; b.x = xb_xcc_id(); b.st = st;
  if (threadIdx.x == 0) (void)xb_add(&bar[XB_XCNT(b.x)], 1u);
  return b;
}
DI void xcd_barrier_complete(unsigned* bar, unsigned x, unsigned& nloc, unsigned& nx) {
  const unsigned G = gridDim.x * gridDim.y * gridDim.z;
  unsigned sum, cnt, mine, sp = 0u;
  for (;;) {
    sum = 0u; cnt = 0u; mine = 0u;
#pragma unroll
    for (unsigned j = 0; j < 16; ++j) { const unsigned c = xb_ld(&bar[XB_XCNT(j)]); sum += c; cnt += (c > 0u) ? 1u : 0u; mine = (j == x) ? c : mine; }
    if (sum == G) break;
    __builtin_amdgcn_s_sleep(1);
    if ((++sp & 255u) == 0u) { if (xb_ld(&bar[XB_TMO])) break; if (sp > XB_SPIN_CAP) { atomicAdd(&bar[XB_TMO], 1u); break; } }
  }
  nloc = mine > 0u ? mine : 1u; nx = cnt > 0u ? cnt : 1u;
}
DI void xcd_barrier(XcdBarrier b) {
  asm volatile("s_waitcnt vmcnt(0)" ::: "memory");
  __syncthreads();
  if (threadIdx.x == 0) {
    unsigned* bar = b.bar;
    asm volatile("" : "+s"(bar));
    b.x = xb_xcc_id();
    __builtin_amdgcn_s_waitcnt(0);
    unsigned nloc = b.st[0], nx = b.st[1];
    if (nloc == 0u) { xcd_barrier_complete(bar, b.x, nloc, nx); b.st[0] = nloc; b.st[1] = nx; }
    const unsigned old = xb_add(&bar[XB_XSUB(b.x)], 1u);
    const unsigned gen = old / nloc;
    if (old + 1u == (gen + 1u) * nloc) {
      __builtin_amdgcn_fence(__ATOMIC_RELEASE, "agent");
      asm volatile("s_waitcnt vmcnt(0)" ::: "memory");
      const unsigned og = xb_add(&bar[XB_TOP], 1u);
      const unsigned tg = og / nx;
      if (og + 1u == (tg + 1u) * nx) xb_add(&bar[XB_TOPGEN], 1u);
      else XB_SPIN(xb_ld(&bar[XB_TOPGEN]) == tg, bar);
      __builtin_amdgcn_fence(__ATOMIC_ACQUIRE, "agent");
      xb_add(&bar[XB_XGEN(b.x)], 1u);
      asm volatile("s_waitcnt vmcnt(0)" ::: "memory");
    } else {
      XB_SPIN(xb_ld(&bar[XB_XGEN(b.x)]) == gen, bar);
      __builtin_amdgcn_fence(__ATOMIC_ACQUIRE, "agent");
      asm volatile("s_waitcnt vmcnt(0)" ::: "memory");
    }
  }
  __syncthreads();
}

constexpr int LDT = 72;
constexpr int GEMM_BUF = 2 * 256 * LDT;
constexpr int SMEM_BYTES = 2 * GEMM_BUF * 2 + 1024;
DI int pop_item(unsigned* ctrs, int q, int* s_item) {
  __syncthreads();
  if (threadIdx.x == 0) *s_item = (int)atomicAdd(ctrs + q * 16, 1u);
  __syncthreads();
  return *s_item;
}
#define FOR_QUEUES(q, j, NQ_EXPR) \
  for (int qq_ = 0, x0_ = (int)(xb_xcc_id() & 7u); qq_ < 8; ++qq_) { const int q = (x0_ + qq_) & 7; const int nq_ = (NQ_EXPR); \
    for (;;) { const int j = pop_item(ctr, q, s_item); if (j >= nq_) break;
#define END_QUEUES }}
DI int q_mtiles(int q, int mtiles) { return (mtiles - q + 7) >> 3; }

DI int wi_colmap(int n) {
  if (n < 1984) return n;
  if (n < 2752) return n + 4;
  if (n < 2756) return 1984 + (n - 2752);
  return -1;
}
DI void transpose_w(const float* __restrict__ src, int Nsrc, u16* __restrict__ dst, int Npad, int K, bool permute,
                    const float* __restrict__ g, int gt, int nth, int ldd = 0) {
  if (ldd == 0) ldd = K;
  const int total = Npad * (K >> 3);
  for (int i = gt; i < total; i += nth) {
    const int n = i % Npad, k8 = i / Npad;
    const int on = permute ? wi_colmap(n) : n;
    float v[8];
#pragma unroll
    for (int j = 0; j < 8; ++j) {
      float x = (on >= 0) ? src[(size_t)(k8 * 8 + j) * Nsrc + on] : 0.f;
      if (g) x *= g[k8 * 8 + j];
      v[j] = x;
    }
    *(uint4*)(dst + (size_t)n * ldd + k8 * 8) = make_uint4(pk2(v[0], v[1]), pk2(v[2], v[3]), pk2(v[4], v[5]), pk2(v[6], v[7]));
  }
}
DI void convert8(const float* __restrict__ src, u16* __restrict__ dst) {
  const float4 a = ((const float4*)src)[0], b = ((const float4*)src)[1];
  *(uint4*)dst = make_uint4(pk2(a.x, a.y), pk2(a.z, a.w), pk2(b.x, b.y), pk2(b.z, b.w));
}

DI void phase_prep(const Params& p) {
  const int nth = gridDim.x * NTH, gt = blockIdx.x * NTH + tid();
  char* ws = p.ws;
  u16* Xb = (u16*)(ws + W_XB);
  for (int i = gt; i < MT * D / 8; i += nth) {
    const size_t e = (size_t)i * 8;
    const float* src = e < (size_t)MP * D ? p.x_prompt + e : p.x_sample + (e - (size_t)MP * D);
    convert8(src, Xb + e);
  }
  u16* memb = (u16*)(ws + W_MEMB);
  for (int i = gt; i < 1024 * 1024 / 8; i += nth) convert8(p.mem_prompt + (size_t)i * 8, memb + (size_t)i * 8);
  for (int l = 0; l < 2; ++l) {
    transpose_w(p.w_in + (size_t)l * D * DIN, DIN, (u16*)(ws + W_WIN) + (size_t)l * N1 * 1024, N1, 1024, true, nullptr, gt, nth);
    transpose_w(p.w_uq + (size_t)l * 384 * 768, 768, (u16*)(ws + W_WUQ) + (size_t)l * 768 * 384, 768, 384, false, p.qn_g + l * 384, gt, nth);
    transpose_w(p.w_ukv + (size_t)l * 256 * 1024, 1024, (u16*)(ws + W_WUKV) + (size_t)l * 1024 * 256, 1024, 256, false, nullptr, gt, nth);
    transpose_w(p.w_ukv + (size_t)l * 256 * 1024, 1024, (u16*)(ws + W_WUKVF) + (size_t)l * 1024 * 256, 1024, 256, false, p.kvn_g + l * 256, gt, nth);
    transpose_w(p.w_memkv + (size_t)l * 1024 * 512, 512, (u16*)(ws + W_WMKV) + (size_t)l * 512 * 1024, 512, 1024, false, nullptr, gt, nth);
    transpose_w(p.w_out + (size_t)l * 1024 * 1024, 1024, (u16*)(ws + W_WOUT) + (size_t)l * 1024 * GLD, 1024, 1024, false, nullptr, gt, nth, GLD);
  }
  float2* tab = (float2*)(ws + W_TAB);
  for (int i = gt; i < 4096 * 32; i += nth) {
    const int pos = i >> 5, c = i & 31;
    const float inv = powf(10000.f, -(float)c / 32.f);
    const float ang = (float)pos * inv;
    float s, co; sincosf(ang, &s, &co);
    tab[i] = make_float2(co, s);
  }
}

DI void phase_cacheconv(const Params& p, int l) {
  const int nth = gridDim.x * NTH, gt = blockIdx.x * NTH + tid();
  char* ws = p.ws;
  {
    const float* src = p.c_fk + (size_t)l * BS * PAST * 256; u16* dst = (u16*)(ws + W_FKBS);
    for (int i = gt; i < BS * PAST * 256 / 8; i += nth) {
      const int c8 = i & 31, bt = i >> 5, b = bt >> 11, t = bt & 2047;
      convert8(src + (size_t)i * 8, dst + ((size_t)(b * TAS + t) * 256 + c8 * 8));
    }
  }
  {
    const float* src = p.c_lat + (size_t)l * BS * PAST * 256; u16* dst = (u16*)(ws + W_LATC);
    for (int i = gt; i < BS * PAST * 256 / 8; i += nth) convert8(src + (size_t)i * 8, dst + (size_t)i * 8);
  }
  {
    const float* src = p.c_kr + (size_t)l * BS * PAST * 64; u16* dst = (u16*)(ws + W_KRBS);
    for (int i = gt; i < BS * PAST * 64 / 8; i += nth) {
      const int c8 = i & 7, bt = i >> 3, b = bt >> 11, t = bt & 2047;
      convert8(src + (size_t)i * 8, dst + ((size_t)(b * TAS + t) * 64 + c8 * 8));
    }
  }
  {
    const float* src = p.c_mk + (size_t)l * BS * NMEM * 256; u16* dst = (u16*)(ws + W_MEMKS);
    for (int i = gt; i < BS * NMEM * 256 / 8; i += nth) convert8(src + (size_t)i * 8, dst + (size_t)i * 8);
  }
  {
    const float* src = p.c_fv + (size_t)l * BS * PAST * 256; u16* dst = (u16*)(ws + W_FVTS);
    for (int i = gt; i < BS * (PAST / 8) * 256; i += nth) {
      const int c = i & 255, t8 = (i >> 8) & 255, b = i >> 16;
      float v[8];
#pragma unroll
      for (int j = 0; j < 8; ++j) v[j] = src[((size_t)(b * PAST + t8 * 8 + j)) * 256 + c];
      *(uint4*)(dst + ((size_t)(b * 256 + c) * TAS + t8 * 8)) = make_uint4(pk2(v[0], v[1]), pk2(v[2], v[3]), pk2(v[4], v[5]), pk2(v[6], v[7]));
    }
  }
  {
    const float* src = p.c_mv + (size_t)l * BS * NMEM * 256; u16* dst = (u16*)(ws + W_MEMVTS);
    for (int i = gt; i < BS * (NMEM / 8) * 256; i += nth) {
      const int c = i & 255, t8 = (i >> 8) & 31, b = i >> 13;
      float v[8];
#pragma unroll
      for (int j = 0; j < 8; ++j) v[j] = src[((size_t)(b * NMEM + t8 * 8 + j)) * 256 + c];
      *(uint4*)(dst + ((size_t)(b * 256 + c) * NMEM + t8 * 8)) = make_uint4(pk2(v[0], v[1]), pk2(v[2], v[3]), pk2(v[4], v[5]), pk2(v[6], v[7]));
    }
  }
}

template <bool AF32>
DI void gemm_gload(const void* __restrict__ Aptr, int lda, const u16* __restrict__ Bt, int ldb, int m0, int n0, int k0,
                   unsigned offA, unsigned offB, u32x4 (&ra)[4], u32x4 (&rb)[4], f32x4 (&rf)[8]) {
  constexpr int ES = AF32 ? 4 : 2;
  const char* ab = (const char*)Aptr + ((size_t)m0 * lda + k0) * ES;
  const char* bb = (const char*)Bt + ((size_t)n0 * ldb + k0) * 2;
#pragma unroll
  for (int i = 0; i < 4; ++i) {
    if constexpr (AF32) {
      const char* s = ab + (size_t)i * 64 * lda * 4 + offA;
      rf[2 * i] = *(const f32x4*)s; rf[2 * i + 1] = *(const f32x4*)(s + 16);
    } else {
      ra[i] = *(const u32x4*)(ab + (size_t)i * 64 * lda * 2 + offA);
    }
    rb[i] = *(const u32x4*)(bb + (size_t)i * 64 * ldb * 2 + offB);
  }
}
template <bool AF32, bool SSQ>
DI void gemm_mainloop(const void* __restrict__ Aptr, int lda, const u16* __restrict__ Bt, int ldb, int K, int m0, int n0,
                      char* smem, f32x16 (&acc)[4][2]) {
  u16* As = (u16*)smem; u16* Bs = As + 256 * LDT; float* rs_lds = (float*)(smem + 2 * GEMM_BUF * 2);
  const int t = tid(), lane = t & 63, w = t >> 6, g = lane >> 5, r = lane & 31;
  const int wm = w >> 2, wn = w & 3;
  const int lrow = t >> 3, lkc = t & 7;
  if constexpr (SSQ) {
    const int row = t >> 1, half = t & 1, kh = K >> 1;
    const u16* ap = (const u16*)Aptr + (size_t)(m0 + row) * lda + half * kh;
    float s = 0.f;
    for (int c = 0; c < kh; c += 8) {
      const u32x4 u = *(const u32x4*)(ap + c);
      s += bflo(u.x) * bflo(u.x) + bfhi(u.x) * bfhi(u.x) + bflo(u.y) * bflo(u.y) + bfhi(u.y) * bfhi(u.y);
      s += bflo(u.z) * bflo(u.z) + bfhi(u.z) * bfhi(u.z) + bflo(u.w) * bflo(u.w) + bfhi(u.w) * bfhi(u.w);
    }
    s += __shfl_xor(s, 1);
    if (half == 0) rs_lds[row] = rsqrtf(s / (float)K + EPS);
  }
  u32x4 ra[4], rb[4];
  f32x4 rf[8];
#pragma unroll
  for (int mi = 0; mi < 4; ++mi)
#pragma unroll
    for (int ni = 0; ni < 2; ++ni)
#pragma unroll
      for (int i = 0; i < 16; ++i) acc[mi][ni][i] = 0.f;

  const int KT = K >> 6;
  const unsigned offA = (unsigned)(lrow * lda + lkc * 8) * (AF32 ? 4u : 2u);
  const unsigned offB = (unsigned)(lrow * ldb + lkc * 8) * 2u;
  gemm_gload<AF32>(Aptr, lda, Bt, ldb, m0, n0, 0, offA, offB, ra, rb, rf);
  for (int kt = -1; kt < KT; ++kt) {
    if (kt + 1 < KT) {
      u16* Aw = As + ((kt + 1) & 1) * GEMM_BUF;
      u16* Bw = Bs + ((kt + 1) & 1) * GEMM_BUF;
#pragma unroll
      for (int i = 0; i < 4; ++i) {
        const int row = lrow + 64 * i;
        if constexpr (AF32) {
          const f32x4 a = rf[2 * i], b = rf[2 * i + 1];
          ra[i] = u32x4{pk2(a.x, a.y), pk2(a.z, a.w), pk2(b.x, b.y), pk2(b.z, b.w)};
        }
        *(u32x4*)(Aw + row * LDT + lkc * 8) = ra[i];
        *(u32x4*)(Bw + row * LDT + lkc * 8) = rb[i];
      }
      if (kt + 2 < KT) gemm_gload<AF32>(Aptr, lda, Bt, ldb, m0, n0, (kt + 2) << 6, offA, offB, ra, rb, rf);
    }
    __builtin_amdgcn_sched_barrier(0);
    if (kt >= 0) {
      const u16* Ar = As + (kt & 1) * GEMM_BUF;
      const u16* Br = Bs + (kt & 1) * GEMM_BUF;
#pragma unroll
      for (int ks = 0; ks < 4; ++ks) {
        bf16x8 wf[2], xf[4];
#pragma unroll
        for (int ni = 0; ni < 2; ++ni) wf[ni] = *(const bf16x8*)(Br + (wn * 64 + ni * 32 + r) * LDT + ks * 16 + g * 8);
#pragma unroll
        for (int mi = 0; mi < 4; ++mi) xf[mi] = *(const bf16x8*)(Ar + (wm * 128 + mi * 32 + r) * LDT + ks * 16 + g * 8);
#pragma unroll
        for (int mi = 0; mi < 4; ++mi)
#pragma unroll
          for (int ni = 0; ni < 2; ++ni) acc[mi][ni] = MFMA(wf[ni], xf[mi], acc[mi][ni]);
      }
    }
    __syncthreads();
  }
}

enum { EPI_H = 0, EPI_MEMKV = 1, EPI_Q = 2, EPI_KV = 3, EPI_KVC = 4, EPI_OUT = 5 };

template <int EPI>
DI void gemm_epilogue(const Params& p, int l, f32x16 (&acc)[4][2], int m0, int n0, char* smem, int mrows) {
  const float* rs_lds = (const float*)(smem + 2 * GEMM_BUF * 2);
  const int t = tid(), lane = t & 63, w = t >> 6, g = lane >> 5, r = lane & 31;
  const int wm = w >> 2, wn = w & 3;
  const int nw = n0 + wn * 64;
  char* ws = p.ws; float* out = p.out;
  const float2* tab = (const float2*)(ws + W_TAB);
#pragma unroll
  for (int mi = 0; mi < 4; ++mi) {
    const int lr = wm * 128 + mi * 32 + r;
    const int row = m0 + lr;
    if (row >= mrows) continue;
    if constexpr (EPI == EPI_H) {
      const bool is_s = row >= MP;
      const int b = is_s ? ((row - MP) >> 4) : (row >> 12);
      const int tt = is_s ? ((row - MP) & 15) : (row & 4095);
      if (nw < SEG_CKV) {
        u16* d = (u16*)(ws + W_CQ) + (size_t)row * 384;
#pragma unroll
        for (int ni = 0; ni < 2; ++ni)
#pragma unroll
          for (int j = 0; j < 4; ++j) { const int n = nw + ni * 32 + 8 * j + 4 * g; st4bf(d + n, acc[mi][ni][4 * j], acc[mi][ni][4 * j + 1], acc[mi][ni][4 * j + 2], acc[mi][ni][4 * j + 3]); }
      } else if (nw < SEG_KR) {
        u16* d = (u16*)(ws + W_CKV) + (size_t)row * 256;
        float* lo = is_s ? out + O_SLAT + (size_t)l * MS * 256 + (size_t)(row - MP) * 256 : out + O_PLAT + (size_t)l * MP * 256 + (size_t)row * 256;
#pragma unroll
        for (int ni = 0; ni < 2; ++ni)
#pragma unroll
          for (int j = 0; j < 4; ++j) {
            const int c = nw - SEG_CKV + ni * 32 + 8 * j + 4 * g;
            st4bf(d + c, acc[mi][ni][4 * j], acc[mi][ni][4 * j + 1], acc[mi][ni][4 * j + 2], acc[mi][ni][4 * j + 3]);
            *(float4*)(lo + c) = make_float4(acc[mi][ni][4 * j], acc[mi][ni][4 * j + 1], acc[mi][ni][4 * j + 2], acc[mi][ni][4 * j + 3]);
          }
      } else if (nw == SEG_KR) {
        const int pos = is_s ? PAST + tt : tt;
        float* ko = is_s ? out + O_SKR + (size_t)l * MS * 64 + (size_t)(row - MP) * 64 : out + O_PKR + (size_t)l * MP * 64 + (size_t)row * 64;
        u16* kb = is_s ? (u16*)(ws + W_KRBS) + (size_t)(b * TAS + PAST + tt) * 64 : (u16*)(ws + W_KRBP) + (size_t)row * 64;
#pragma unroll
        for (int j = 0; j < 4; ++j) {
          const int c = 8 * j + 4 * g;
          float y1[4], y2[4];
#pragma unroll
          for (int i = 0; i < 4; ++i) {
            const float2 cs = tab[pos * 32 + c + i];
            const float x1 = acc[mi][0][4 * j + i], x2 = acc[mi][1][4 * j + i];
            y1[i] = x1 * cs.x - x2 * cs.y; y2[i] = x1 * cs.y + x2 * cs.x;
          }
          *(float4*)(ko + c) = make_float4(y1[0], y1[1], y1[2], y1[3]);
          *(float4*)(ko + 32 + c) = make_float4(y2[0], y2[1], y2[2], y2[3]);
          st4bf(kb + c, y1[0], y1[1], y1[2], y1[3]);
          st4bf(kb + 32 + c, y2[0], y2[1], y2[2], y2[3]);
          __builtin_amdgcn_sched_barrier(0);
        }
      } else if (nw < SEG_FQ || (nw >= SEG_GFOX && nw < SEG_MQ) || (nw >= SEG_GMEM && nw < SEG_FL)) {
        const int gc0 = nw < SEG_FQ ? nw - SEG_GMLA : (nw < SEG_MQ ? 512 + nw - SEG_GFOX : 768 + nw - SEG_GMEM);
        u16* d = (u16*)(ws + W_GATE) + (size_t)row * GLD + gc0;
#pragma unroll
        for (int ni = 0; ni < 2; ++ni)
#pragma unroll
          for (int j = 0; j < 4; ++j) {
            const int c = ni * 32 + 8 * j + 4 * g;
            st4bf(d + c, silu(acc[mi][ni][4 * j]), silu(acc[mi][ni][4 * j + 1]), silu(acc[mi][ni][4 * j + 2]), silu(acc[mi][ni][4 * j + 3]));
          }
      } else if (nw < SEG_FK) {
        u16* d = (u16*)(ws + W_FQ) + (size_t)row * 256 + (nw - SEG_FQ);
#pragma unroll
        for (int ni = 0; ni < 2; ++ni)
#pragma unroll
          for (int j = 0; j < 4; ++j) { const int c = ni * 32 + 8 * j + 4 * g; st4bf(d + c, acc[mi][ni][4 * j], acc[mi][ni][4 * j + 1], acc[mi][ni][4 * j + 2], acc[mi][ni][4 * j + 3]); }
      } else if (nw < SEG_FV) {
        const int c0 = nw - SEG_FK;
        float* fo = (is_s ? out + O_SFK + (size_t)l * MS * 256 + (size_t)(row - MP) * 256 : out + O_PFK + (size_t)l * MP * 256 + (size_t)row * 256) + c0;
        u16* d = (is_s ? (u16*)(ws + W_FKBS) + (size_t)(b * TAS + PAST + tt) * 256 : (u16*)(ws + W_FKBP) + (size_t)row * 256) + c0;
#pragma unroll
        for (int ni = 0; ni < 2; ++ni)
#pragma unroll
          for (int j = 0; j < 4; ++j) {
            const int c = ni * 32 + 8 * j + 4 * g;
            *(float4*)(fo + c) = make_float4(acc[mi][ni][4 * j], acc[mi][ni][4 * j + 1], acc[mi][ni][4 * j + 2], acc[mi][ni][4 * j + 3]);
            st4bf(d + c, acc[mi][ni][4 * j], acc[mi][ni][4 * j + 1], acc[mi][ni][4 * j + 2], acc[mi][ni][4 * j + 3]);
          }
      } else if (nw < SEG_GFOX) {
        const int c0 = nw - SEG_FV;
        float* fo = (is_s ? out + O_SFV + (size_t)l * MS * 256 + (size_t)(row - MP) * 256 : out + O_PFV + (size_t)l * MP * 256 + (size_t)row * 256) + c0;
        u16* d = is_s ? (u16*)(ws + W_FVTS) + (size_t)(b * 256 + c0) * TAS + PAST + tt : (u16*)(ws + W_FVTP) + (size_t)(b * 256 + c0) * 4096 + tt;
        const size_t ldt = is_s ? TAS : 4096;
#pragma unroll
        for (int ni = 0; ni < 2; ++ni)
#pragma unroll
          for (int j = 0; j < 4; ++j) {
            const int c = ni * 32 + 8 * j + 4 * g;
            *(float4*)(fo + c) = make_float4(acc[mi][ni][4 * j], acc[mi][ni][4 * j + 1], acc[mi][ni][4 * j + 2], acc[mi][ni][4 * j + 3]);
#pragma unroll
            for (int i = 0; i < 4; ++i) d[(size_t)(c + i) * ldt] = (u16)(pk2(acc[mi][ni][4 * j + i], 0.f) & 0xffffu);
          }
      } else if (nw < SEG_GMEM) {
        u16* d = (u16*)(ws + W_MQ) + (size_t)row * 256 + (nw - SEG_MQ);
#pragma unroll
        for (int ni = 0; ni < 2; ++ni)
#pragma unroll
          for (int j = 0; j < 4; ++j) { const int c = ni * 32 + 8 * j + 4 * g; st4bf(d + c, acc[mi][ni][4 * j], acc[mi][ni][4 * j + 1], acc[mi][ni][4 * j + 2], acc[mi][ni][4 * j + 3]); }
      } else {
        if (g == 0) {
          float lf[4];
#pragma unroll
          for (int i = 0; i < 4; ++i) {
            const float z = acc[mi][0][i] + p.b_f[l * 4 + i];
            lf[i] = fminf(z, 0.f) - log1pf(expf(-fabsf(z)));
          }
          float* fo = is_s ? out + O_SLOGF + (size_t)l * MS * 4 + (size_t)(row - MP) * 4 : out + O_PLOGF + (size_t)l * MP * 4 + (size_t)row * 4;
          *(float4*)fo = make_float4(lf[0], lf[1], lf[2], lf[3]);
        }
      }
    } else if constexpr (EPI == EPI_MEMKV) {
      const int b = row >> 8, m = row & 255;
#pragma unroll
      for (int ni = 0; ni < 2; ++ni)
#pragma unroll
        for (int j = 0; j < 4; ++j) {
          const int n = nw + ni * 32 + 8 * j + 4 * g;
          const float4 v = make_float4(acc[mi][ni][4 * j], acc[mi][ni][4 * j + 1], acc[mi][ni][4 * j + 2], acc[mi][ni][4 * j + 3]);
          if (nw < 256) {
            *(float4*)(out + O_PMK + (size_t)l * 1024 * 256 + (size_t)row * 256 + n) = v;
            st4bf((u16*)(ws + W_MEMKP) + (size_t)l * 1024 * 256 + (size_t)row * 256 + n, v.x, v.y, v.z, v.w);
          } else {
            const int c = n - 256;
            *(float4*)(out + O_PMV + (size_t)l * 1024 * 256 + (size_t)row * 256 + c) = v;
            u16* d = (u16*)(ws + W_MEMVTP) + (size_t)l * 1024 * 256 + (size_t)(b * 256 + c) * NMEM + m;
            d[0] = (u16)(pk2(v.x, 0.f) & 0xffffu); d[NMEM] = (u16)(pk2(v.y, 0.f) & 0xffffu);
            d[2 * NMEM] = (u16)(pk2(v.z, 0.f) & 0xffffu); d[3 * NMEM] = (u16)(pk2(v.w, 0.f) & 0xffffu);
          }
        }
    } else if constexpr (EPI == EPI_Q) {
      const float rs = rs_lds[lr];
      const bool is_s = row >= MP;
      const int tt = is_s ? ((row - MP) & 15) : (row & 4095);
      const int pos = is_s ? PAST + tt : tt;
      u16* d = (u16*)(ws + W_XB) + (size_t)row * 768 + nw;
      if ((nw % 192) == 128) {
#pragma unroll
        for (int j = 0; j < 4; ++j) {
          const int c = 8 * j + 4 * g;
          float y1[4], y2[4];
#pragma unroll
          for (int i = 0; i < 4; ++i) {
            const float2 cs = tab[pos * 32 + c + i];
            const float x1 = acc[mi][0][4 * j + i] * rs, x2 = acc[mi][1][4 * j + i] * rs;
            y1[i] = x1 * cs.x - x2 * cs.y; y2[i] = x1 * cs.y + x2 * cs.x;
          }
          st4bf(d + c, y1[0], y1[1], y1[2], y1[3]);
          st4bf(d + 32 + c, y2[0], y2[1], y2[2], y2[3]);
          __builtin_amdgcn_sched_barrier(0);
        }
      } else {
#pragma unroll
        for (int ni = 0; ni < 2; ++ni)
#pragma unroll
          for (int j = 0; j < 4; ++j) {
            const int c = ni * 32 + 8 * j + 4 * g;
            st4bf(d + c, acc[mi][ni][4 * j] * rs, acc[mi][ni][4 * j + 1] * rs, acc[mi][ni][4 * j + 2] * rs, acc[mi][ni][4 * j + 3] * rs);
          }
      }
    } else if constexpr (EPI == EPI_KV || EPI == EPI_KVC) {
      float rs = 1.f; int b, tt; bool is_s;
      if constexpr (EPI == EPI_KV) {
        rs = rs_lds[lr]; is_s = row >= MP;
        b = is_s ? ((row - MP) >> 4) : (row >> 12);
        tt = is_s ? PAST + ((row - MP) & 15) : (row & 4095);
      } else { is_s = true; b = row >> 11; tt = row & 2047; }
      const int head = nw >> 8, c0 = nw & 255;
      const size_t T = is_s ? TAS : 4096;
      u16* knb = (u16*)(ws + (is_s ? W_KNS : W_KNP)); u16* vtb = (u16*)(ws + (is_s ? W_VTS : W_VTP));
      if (c0 < 128) {
        u16* d = knb + ((size_t)(b * 4 + head) * T + tt) * 128 + c0;
#pragma unroll
        for (int ni = 0; ni < 2; ++ni)
#pragma unroll
          for (int j = 0; j < 4; ++j) {
            const int c = ni * 32 + 8 * j + 4 * g;
            st4bf(d + c, acc[mi][ni][4 * j] * rs, acc[mi][ni][4 * j + 1] * rs, acc[mi][ni][4 * j + 2] * rs, acc[mi][ni][4 * j + 3] * rs);
          }
      } else {
        u16* d = vtb + ((size_t)(b * 4 + head) * 128 + (c0 - 128)) * T + tt;
#pragma unroll
        for (int ni = 0; ni < 2; ++ni)
#pragma unroll
          for (int j = 0; j < 4; ++j) {
            const int c = ni * 32 + 8 * j + 4 * g;
#pragma unroll
            for (int i = 0; i < 4; ++i) d[(size_t)(c + i) * T] = (u16)(pk2(acc[mi][ni][4 * j + i] * rs, 0.f) & 0xffffu);
          }
      }
    } else if constexpr (EPI == EPI_OUT) {
      const float* res = (l == 0) ? (row < MP ? p.x_prompt + (size_t)row * 1024 : p.x_sample + (size_t)(row - MP) * 1024) : out + O_Y + (size_t)row * 1024;
      float* zo = out + O_Y + (size_t)row * 1024;
#pragma unroll
      for (int ni = 0; ni < 2; ++ni)
#pragma unroll
        for (int j = 0; j < 4; ++j) {
          const int n = nw + ni * 32 + 8 * j + 4 * g;
          const float4 x = *(const float4*)(res + n);
          *(float4*)(zo + n) = make_float4(ALPHA * x.x + acc[mi][ni][4 * j], ALPHA * x.y + acc[mi][ni][4 * j + 1],
                                           ALPHA * x.z + acc[mi][ni][4 * j + 2], ALPHA * x.w + acc[mi][ni][4 * j + 3]);
        }
    }
  }
}

template <bool AF32, bool SSQ, int EPI>
DI void gemm_tile(const Params& p, int l, const void* A, int lda, const u16* Bt, int ldb, int K, int m0, int n0, char* smem, int mrows) {
  f32x16 acc[4][2];
  gemm_mainloop<AF32, SSQ>(A, lda, Bt, ldb, K, m0, n0, smem, acc);
  gemm_epilogue<EPI>(p, l, acc, m0, n0, smem, mrows);
}

typedef __attribute__((ext_vector_type(4))) float g8f4;
constexpr int G8_HALF = 128, G8_BK = 64, G8_HT = G8_HALF * G8_BK;
DI int g8_lds_byte(int r, int c) {
  int st = (r >> 4) * 2 + (c >> 5), rr = r & 15, cc = c & 31, ob = rr * 64 + cc * 2;
  return st * 1024 + (ob ^ (((ob >> 9) & 1) << 5));
}
DI void g8_stage_rc(int b, int& R, int& C) {
  int st = b / 1024, sb = b % 1024, swz = sb ^ (((sb >> 9) & 1) << 5);
  R = (st >> 1) * 16 + swz / 64; C = (st & 1) * 32 + (swz % 64) / 2;
}
DI void gemm8_mainloop(const u16* __restrict__ W, int ldw, const u16* __restrict__ X, int ldx, int K,
                       int brow, int bcol, char* smem, g8f4 (&acc)[2][2][4][2]) {
  u16* shm = (u16*)smem;
  #define SA(b,h) (shm+((b)*2+(h))*G8_HT)
  #define SB(b,h) (shm+(4+(b)*2+(h))*G8_HT)
  #define STAGE(P,BASE,LD,br,kt) do{long _g=(long)(br)*(LD)+(long)(kt)*G8_BK; \
    for(int _i=0;_i<2;++_i){int _b=tx*16+_i*8192;int _r,_c;g8_stage_rc(_b,_r,_c); \
      __builtin_amdgcn_global_load_lds((const unsigned*)(BASE+_g+(long)_r*(LD)+_c), \
        (__attribute__((address_space(3))) unsigned*)((char*)(P)+_b),16,0,0);}}while(0)
  #define LDA(dst,b,h) for(int m=0;m<4;++m)for(int k=0;k<2;++k) \
    dst[m][k]=*reinterpret_cast<const bf16x8*>((char*)SA(b,h)+g8_lds_byte(wr*64+m*16+fr,k*32+fq*8))
  #define LDB(dst,b,h) for(int n=0;n<2;++n)for(int k=0;k<2;++k) \
    dst[n][k]=*reinterpret_cast<const bf16x8*>((char*)SB(b,h)+g8_lds_byte(wc*32+n*16+fr,k*32+fq*8))
  #define MMA(ai,bj,At,Bt) do{__builtin_amdgcn_s_setprio(1); \
    for(int m=0;m<4;++m)for(int n=0;n<2;++n)for(int k=0;k<2;++k) \
      acc[ai][bj][m][n]=__builtin_amdgcn_mfma_f32_16x16x32_bf16(At[m][k],Bt[n][k],acc[ai][bj][m][n],0,0,0); \
    __builtin_amdgcn_s_setprio(0);}while(0)
  #define WAIT_V(n) asm volatile("s_waitcnt vmcnt(" #n ")":::"memory")
  #define WAIT_L(n) asm volatile("s_waitcnt lgkmcnt(" #n ")":::"memory")
  #define BAR __builtin_amdgcn_s_barrier()
  #define SCHED __builtin_amdgcn_sched_barrier(0)
  const int tx = tid();
  const int wid = tx >> 6, lane = tx & 63, wr = wid >> 2, wc = wid & 3, fr = lane & 15, fq = lane >> 4;
#pragma unroll
  for (int a_ = 0; a_ < 2; ++a_)
#pragma unroll
    for (int b_ = 0; b_ < 2; ++b_)
#pragma unroll
      for (int m = 0; m < 4; ++m)
#pragma unroll
        for (int n = 0; n < 2; ++n) acc[a_][b_][m][n] = g8f4{0.f, 0.f, 0.f, 0.f};
  bf16x8 At[4][2], B0[2][2], B1[2][2];
  const int nt = K / G8_BK;
  const u16* A = W; const u16* Bt = X;
  STAGE(SB(0,0),Bt,ldx,bcol,0); STAGE(SA(0,0),A,ldw,brow,0);
  STAGE(SB(0,1),Bt,ldx,bcol+G8_HALF,0); STAGE(SA(0,1),A,ldw,brow+G8_HALF,0);
  if(wr==1)BAR;
  WAIT_V(4); BAR;
  STAGE(SB(1,0),Bt,ldx,bcol,1); STAGE(SA(1,0),A,ldw,brow,1); STAGE(SB(1,1),Bt,ldx,bcol+G8_HALF,1);
  WAIT_V(6); BAR;
  for(int t=0;t<nt-2;t+=2){
    LDB(B0,0,0); SCHED; LDA(At,0,0); STAGE(SA(1,1),A,ldw,brow+G8_HALF,t+1);
    WAIT_L(8); BAR; WAIT_L(0); MMA(0,0,At,B0); BAR; SCHED;
    LDB(B1,0,1); STAGE(SB(0,0),Bt,ldx,bcol,t+2);
    BAR; WAIT_L(0); MMA(0,1,At,B1); BAR;
    LDA(At,0,1); STAGE(SA(0,0),A,ldw,brow,t+2);
    BAR; WAIT_L(0); MMA(1,0,At,B0); BAR; SCHED;
    STAGE(SB(0,1),Bt,ldx,bcol+G8_HALF,t+2);
    WAIT_V(6); BAR; MMA(1,1,At,B1); BAR;
    LDB(B0,1,0); SCHED; LDA(At,1,0); STAGE(SA(0,1),A,ldw,brow+G8_HALF,t+2);
    WAIT_L(8); BAR; WAIT_L(0); MMA(0,0,At,B0); BAR; SCHED;
    LDB(B1,1,1); STAGE(SB(1,0),Bt,ldx,bcol,t+3);
    BAR; WAIT_L(0); MMA(0,1,At,B1); BAR;
    LDA(At,1,1); STAGE(SA(1,0),A,ldw,brow,t+3);
    BAR; WAIT_L(0); MMA(1,0,At,B0); BAR; SCHED;
    STAGE(SB(1,1),Bt,ldx,bcol+G8_HALF,t+3);
    WAIT_V(6); BAR; MMA(1,1,At,B1); BAR;
  }
  { LDB(B0,0,0); LDA(At,0,0); STAGE(SA(1,1),A,ldw,brow+G8_HALF,nt-1);
    BAR; WAIT_L(0); MMA(0,0,At,B0); BAR;
    LDB(B1,0,1); BAR; WAIT_L(0); MMA(0,1,At,B1); BAR;
    LDA(At,0,1); WAIT_V(4); BAR; WAIT_L(0); MMA(1,0,At,B0); MMA(1,1,At,B1); BAR; }
  { LDB(B0,1,0); LDA(At,1,0); WAIT_V(2); BAR; WAIT_L(0); MMA(0,0,At,B0); BAR;
    LDB(B1,1,1); WAIT_V(0); BAR; WAIT_L(0); MMA(0,1,At,B1); BAR;
    LDA(At,1,1); BAR; WAIT_L(0); MMA(1,0,At,B0); MMA(1,1,At,B1); BAR; }
  if(wr==0)BAR;
  #undef SA
  #undef SB
  #undef STAGE
  #undef LDA
  #undef LDB
  #undef MMA
  #undef WAIT_V
  #undef WAIT_L
  #undef BAR
  #undef SCHED
}
DI void gemm8_out_tile(const Params& p, int l, const u16* W, int ldw, const u16* X, int ldx, int K, int brow, int bcol, char* smem, int mrows) {
  g8f4 acc[2][2][4][2];
  gemm8_mainloop(W, ldw, X, ldx, K, brow, bcol, smem, acc);
  const int tx = tid();
  const int wid = tx >> 6, lane = tx & 63, wr = wid >> 2, wc = wid & 3, fr = lane & 15, fq = lane >> 4;
  float* out = p.out;
#pragma unroll
  for (int bj = 0; bj < 2; ++bj)
#pragma unroll
    for (int nn = 0; nn < 2; ++nn) {
      const int row = bcol + bj * G8_HALF + wc * 32 + nn * 16 + fr;
      if (row >= mrows) continue;
      const float* res = (l == 0) ? (row < MP ? p.x_prompt + (size_t)row * 1024 : p.x_sample + (size_t)(row - MP) * 1024) : out + O_Y + (size_t)row * 1024;
      float* zo = out + O_Y + (size_t)row * 1024;
#pragma unroll
      for (int ai = 0; ai < 2; ++ai)
#pragma unroll
        for (int m = 0; m < 4; ++m) {
          const int n = brow + ai * G8_HALF + wr * 64 + m * 16 + fq * 4;
          const float4 x = *(const float4*)(res + n);
          const g8f4 v = acc[ai][bj][m][nn];
          *(float4*)(zo + n) = make_float4(ALPHA * x.x + v[0], ALPHA * x.y + v[1], ALPHA * x.z + v[2], ALPHA * x.w + v[3]);
        }
    }
}
DI void gemm8_h_tile(const Params& p, int l, const u16* W, int ldw, const u16* X, int ldx, int K, int brow, int bcol, char* smem) {
  g8f4 acc[2][2][4][2];
  gemm8_mainloop(W, ldw, X, ldx, K, brow, bcol, smem, acc);
  const int tx = tid();
  const int wid = tx >> 6, lane = tx & 63, wr = wid >> 2, wc = wid & 3, fr = lane & 15, fq = lane >> 4;
  char* ws = p.ws; float* out = p.out;
  const float2* tab = (const float2*)(ws + W_TAB);
#pragma unroll
  for (int bj = 0; bj < 2; ++bj)
#pragma unroll
    for (int nn = 0; nn < 2; ++nn) {
      const int row = bcol + bj * G8_HALF + wc * 32 + nn * 16 + fr;
      if (row >= MT) continue;
      const bool is_s = row >= MP;
      const int b = is_s ? ((row - MP) >> 4) : (row >> 12);
      const int tt = is_s ? ((row - MP) & 15) : (row & 4095);
#pragma unroll
      for (int ai = 0; ai < 2; ++ai) {
        const int nw = brow + ai * G8_HALF + wr * 64;
        if (nw == SEG_KR) {
          const int pos = is_s ? PAST + tt : tt;
          float* ko = is_s ? out + O_SKR + (size_t)l * MS * 64 + (size_t)(row - MP) * 64 : out + O_PKR + (size_t)l * MP * 64 + (size_t)row * 64;
          u16* kb = is_s ? (u16*)(ws + W_KRBS) + (size_t)(b * TAS + PAST + tt) * 64 : (u16*)(ws + W_KRBP) + (size_t)row * 64;
#pragma unroll
          for (int m = 0; m < 2; ++m) {
            const int c = m * 16 + fq * 4;
            const g8f4 x1 = acc[ai][bj][m][nn], x2 = acc[ai][bj][m + 2][nn];
            float y1[4], y2[4];
#pragma unroll
            for (int i = 0; i < 4; ++i) { const float2 cs = tab[pos * 32 + c + i]; y1[i] = x1[i] * cs.x - x2[i] * cs.y; y2[i] = x1[i] * cs.y + x2[i] * cs.x; }
            *(float4*)(ko + c) = make_float4(y1[0], y1[1], y1[2], y1[3]);
            *(float4*)(ko + 32 + c) = make_float4(y2[0], y2[1], y2[2], y2[3]);
            st4bf(kb + c, y1[0], y1[1], y1[2], y1[3]);
            st4bf(kb + 32 + c, y2[0], y2[1], y2[2], y2[3]);
          }
        } else if (nw >= SEG_FL) {
          if (fq == 0) {
            const g8f4 z4 = acc[ai][bj][0][nn];
            float lf[4];
#pragma unroll
            for (int i = 0; i < 4; ++i) { const float z = z4[i] + p.b_f[l * 4 + i]; lf[i] = fminf(z, 0.f) - log1pf(expf(-fabsf(z))); }
            float* fo = is_s ? out + O_SLOGF + (size_t)l * MS * 4 + (size_t)(row - MP) * 4 : out + O_PLOGF + (size_t)l * MP * 4 + (size_t)row * 4;
            *(float4*)fo = make_float4(lf[0], lf[1], lf[2], lf[3]);
          }
        } else {
#pragma unroll
          for (int m = 0; m < 4; ++m) {
            const int c = m * 16 + fq * 4;
            const g8f4 v = acc[ai][bj][m][nn];
            if (nw < SEG_CKV) {
              st4bf((u16*)(ws + W_CQ) + (size_t)row * 384 + nw + c, v[0], v[1], v[2], v[3]);
            } else if (nw < SEG_KR) {
              const int cc = nw - SEG_CKV + c;
              st4bf((u16*)(ws + W_CKV) + (size_t)row * 256 + cc, v[0], v[1], v[2], v[3]);
              float* lo = is_s ? out + O_SLAT + (size_t)l * MS * 256 + (size_t)(row - MP) * 256 : out + O_PLAT + (size_t)l * MP * 256 + (size_t)row * 256;
              *(float4*)(lo + cc) = make_float4(v[0], v[1], v[2], v[3]);
            } else if (nw < SEG_FQ || (nw >= SEG_GFOX && nw < SEG_MQ) || (nw >= SEG_GMEM && nw < SEG_FL)) {
              const int gc0 = nw < SEG_FQ ? nw - SEG_GMLA : (nw < SEG_MQ ? 512 + nw - SEG_GFOX : 768 + nw - SEG_GMEM);
              st4bf((u16*)(ws + W_GATE) + (size_t)row * GLD + gc0 + c, silu(v[0]), silu(v[1]), silu(v[2]), silu(v[3]));
            } else if (nw < SEG_FK) {
              st4bf((u16*)(ws + W_FQ) + (size_t)row * 256 + (nw - SEG_FQ) + c, v[0], v[1], v[2], v[3]);
            } else if (nw < SEG_FV) {
              const int cc = nw - SEG_FK + c;
              float* fo = (is_s ? out + O_SFK + (size_t)l * MS * 256 + (size_t)(row - MP) * 256 : out + O_PFK + (size_t)l * MP * 256 + (size_t)row * 256) + cc;
              u16* d = (is_s ? (u16*)(ws + W_FKBS) + (size_t)(b * TAS + PAST + tt) * 256 : (u16*)(ws + W_FKBP) + (size_t)row * 256) + cc;
              *(float4*)fo = make_float4(v[0], v[1], v[2], v[3]);
              st4bf(d, v[0], v[1], v[2], v[3]);
            } else if (nw < SEG_GFOX) {
              const int cc = nw - SEG_FV + c;
              float* fo = (is_s ? out + O_SFV + (size_t)l * MS * 256 + (size_t)(row - MP) * 256 : out + O_PFV + (size_t)l * MP * 256 + (size_t)row * 256) + cc;
              *(float4*)fo = make_float4(v[0], v[1], v[2], v[3]);
              u16* d = is_s ? (u16*)(ws + W_FVTS) + (size_t)(b * 256 + cc) * TAS + PAST + tt : (u16*)(ws + W_FVTP) + (size_t)(b * 256 + cc) * 4096 + tt;
              const size_t ldt = is_s ? TAS : 4096;
#pragma unroll
              for (int i = 0; i < 4; ++i) d[(size_t)i * ldt] = (u16)(pk2(v[i], 0.f) & 0xffffu);
            } else {
              st4bf((u16*)(ws + W_MQ) + (size_t)row * 256 + (nw - SEG_MQ) + c, v[0], v[1], v[2], v[3]);
            }
          }
        }
      }
    }
}

template <bool CACHE>
DI void gemm8_kv_tile(const Params& p, int l, const u16* W, const u16* X, int brow, int bcol, char* smem) {
  float* rs_lds = (float*)(smem + 2 * GEMM_BUF * 2);
  const int tx = tid();
  if constexpr (!CACHE) {
    const int row = tx >> 1, half = tx & 1;
    const u16* ap = X + (size_t)(bcol + row) * 256 + half * 128;
    float s = 0.f;
#pragma unroll
    for (int c = 0; c < 128; c += 8) {
      const u32x4 u = *(const u32x4*)(ap + c);
      s += bflo(u.x) * bflo(u.x) + bfhi(u.x) * bfhi(u.x) + bflo(u.y) * bflo(u.y) + bfhi(u.y) * bfhi(u.y);
      s += bflo(u.z) * bflo(u.z) + bfhi(u.z) * bfhi(u.z) + bflo(u.w) * bflo(u.w) + bfhi(u.w) * bfhi(u.w);
    }
    s += __shfl_xor(s, 1);
    if (half == 0) rs_lds[row] = rsqrtf(s * (1.f / 256.f) + EPS);
  }
  g8f4 acc[2][2][4][2];
  gemm8_mainloop(W, 256, X, 256, 256, brow, bcol, smem, acc);
  const int wid = tx >> 6, lane = tx & 63, wr = wid >> 2, wc = wid & 3, fr = lane & 15, fq = lane >> 4;
  char* ws = p.ws;
#pragma unroll
  for (int bj = 0; bj < 2; ++bj)
#pragma unroll
    for (int nn = 0; nn < 2; ++nn) {
      const int tl = bj * G8_HALF + wc * 32 + nn * 16 + fr;
      const int row = bcol + tl;
      float rs = 1.f; int b, tt; bool is_s;
      if constexpr (CACHE) { is_s = true; b = row >> 11; tt = row & 2047; }
      else {
        if (row >= MT) continue;
        rs = rs_lds[tl]; is_s = row >= MP;
        b = is_s ? ((row - MP) >> 4) : (row >> 12);
        tt = is_s ? PAST + ((row - MP) & 15) : (row & 4095);
      }
      const size_t T = is_s ? TAS : 4096;
      u16* knb = (u16*)(ws + (is_s ? W_KNS : W_KNP)); u16* vtb = (u16*)(ws + (is_s ? W_VTS : W_VTP));
#pragma unroll
      for (int ai = 0; ai < 2; ++ai) {
        const int nw = brow + ai * G8_HALF + wr * 64;
        const int head = nw >> 8, c0 = nw & 255;
        if (c0 < 128) {
          u16* d = knb + ((size_t)(b * 4 + head) * T + tt) * 128 + c0;
#pragma unroll
          for (int m = 0; m < 4; ++m) { const g8f4 v = acc[ai][bj][m][nn]; st4bf(d + m * 16 + fq * 4, v[0] * rs, v[1] * rs, v[2] * rs, v[3] * rs); }
        } else {
          u16* d = vtb + ((size_t)(b * 4 + head) * 128 + (c0 - 128)) * T + tt;
#pragma unroll
          for (int m = 0; m < 4; ++m) {
            const g8f4 v = acc[ai][bj][m][nn];
#pragma unroll
            for (int i = 0; i < 4; ++i) d[(size_t)(m * 16 + fq * 4 + i) * T] = (u16)(pk2(v[i] * rs, 0.f) & 0xffffu);
          }
        }
      }
    }
}

struct AttnItem {
  const u16* q; const u16* k1; const u16* k2; const u16* vt; const float* cum; u16* gate;
  int ldq, ldk1, ldv, qrow0, nq, qpos0, Tk, ntiles, dry;
};

template <int DK>
DI void attn_loadK(const AttnItem& a, int k0, unsigned offK, u32x4 (&rk)[3]) {
  if constexpr (DK == 192) {
    const char* b1 = (const char*)(a.k1 + (size_t)k0 * 128);
    const char* b2 = (const char*)(a.k2 + (size_t)k0 * 64);
#pragma unroll
    for (int i = 0; i < 2; ++i) rk[i] = *(const u32x4*)(b1 + (size_t)i * 8192 + offK);
    rk[2] = *(const u32x4*)(b2 + offK);
  } else {
    const char* b1 = (const char*)(a.k1 + (size_t)k0 * a.ldk1);
    rk[0] = *(const u32x4*)(b1 + offK);
  }
}
template <int DK>
DI void attn_storeK(u16* Ks, int t, u32x4 (&rk)[3]) {
  constexpr int KS = DK + 8;
  if constexpr (DK == 192) {
#pragma unroll
    for (int i = 0; i < 2; ++i) { const int c = t + 512 * i; const int key = c >> 4, kc = c & 15; *(u32x4*)(Ks + key * KS + kc * 8) = rk[i]; }
    { const int key = t >> 3, kc = t & 7; *(u32x4*)(Ks + key * KS + 128 + kc * 8) = rk[2]; }
  } else {
    const int key = t >> 3, kc = t & 7; *(u32x4*)(Ks + key * KS + kc * 8) = rk[0];
  }
}
template <int DV, int MODE>
DI void attn_loadV(const AttnItem& a, int k0, int t, unsigned offV, u32x4 (&rv)[2], float& rc) {
  const char* bv = (const char*)(a.vt + k0);
#pragma unroll
  for (int i = 0; i < DV / 64; ++i) rv[i] = *(const u32x4*)(bv + (size_t)i * 128 * a.ldv + offV);
  if constexpr (MODE == 1) { if (t < 64) rc = a.cum[k0 + t]; }
}
template <int DV, int MODE>
DI void attn_storeV(u16* Vs, float* Cs, int t, u32x4 (&rv)[2], float rc) {
  constexpr int VS = 72;
#pragma unroll
  for (int i = 0; i < DV / 64; ++i) {
    const int c = t + 512 * i; const int d = c >> 3, kc = c & 7;
    const int pl = (kc >> 1) * 16 + 4 * (kc & 1);
    *(uint2*)(Vs + d * VS + pl) = make_uint2(rv[i].x, rv[i].y);
    *(uint2*)(Vs + d * VS + pl + 8) = make_uint2(rv[i].z, rv[i].w);
  }
  if constexpr (MODE == 1) { if (t < 64) Cs[t] = rc * LOG2E; }
}

template <int DK, int DV, int MODE>
DI void attn_item(const AttnItem& a, float sc, char* smem) {
  constexpr int KS = DK + 8;
  constexpr int VS = 72;
  constexpr int STG = 64 * KS * 2 + DV * VS * 2 + 256;
  const int t = tid(), lane = t & 63, w = t >> 6, g = lane >> 5, r = lane & 31;
  const bool wave_active = (w * 32) < a.nq;
  const int ql = w * 32 + r;
  const int qlc = ql < a.nq ? ql : a.nq - 1;
  const int qrow = a.qrow0 + qlc;
  const int qpos = a.qpos0 + qlc;
  const int wq_lo = a.qpos0 + w * 32;
  const int wq_hi = a.qpos0 + ((w * 32 + 31) < a.nq ? (w * 32 + 31) : a.nq - 1);

  bf16x8 qf[DK / 16];
#pragma unroll
  for (int ks = 0; ks < DK / 16; ++ks) qf[ks] = *(const bf16x8*)(a.q + (size_t)qrow * a.ldq + ks * 16 + g * 8);
  f32x16 o[DV / 32];
#pragma unroll
  for (int db = 0; db < DV / 32; ++db)
#pragma unroll
    for (int i = 0; i < 16; ++i) o[db][i] = 0.f;
  float mrun = -1e30f, lsum = 0.f;
  float cq2 = 0.f;
  if constexpr (MODE == 1) cq2 = a.cum[qpos] * LOG2E;

  u32x4 rk[3], rv[2];
  float rc = 0.f;
  const unsigned offK = DK == 192 ? (unsigned)t * 16u : (unsigned)((t >> 3) * a.ldk1 * 2 + (t & 7) * 16);
  const unsigned offV = (unsigned)((t >> 3) * a.ldv * 2 + (t & 7) * 16);
  attn_loadK<DK>(a, 0, offK, rk);
  attn_loadV<DV, MODE>(a, 0, t, offV, rv, rc);
  for (int kt = -1; kt < a.ntiles; ++kt) {
    const int k0 = kt * 64;
    if (kt + 1 < a.ntiles) {
      char* sw = smem + ((kt + 1) & 1) * STG;
      attn_storeK<DK>((u16*)sw, t, rk);
      attn_storeV<DV, MODE>((u16*)(sw + 64 * KS * 2), (float*)(sw + 64 * KS * 2 + DV * VS * 2), t, rv, rc);
      if (kt + 2 < a.ntiles) { attn_loadK<DK>(a, k0 + 128, offK, rk); attn_loadV<DV, MODE>(a, k0 + 128, t, offV, rv, rc); }
    }
    __builtin_amdgcn_sched_barrier(0);
    const char* sr = smem + (kt & 1) * STG;
    const u16* Ks = (const u16*)sr; const u16* Vs = (const u16*)(sr + 64 * KS * 2); const float* Cs = (const float*)(sr + 64 * KS * 2 + DV * VS * 2);
    bool do_tile = wave_active && kt >= 0;
    if constexpr (MODE == 0) do_tile = do_tile && (kt <= (wq_lo >> 6));
    if constexpr (MODE == 1) do_tile = do_tile && (k0 <= wq_hi);
    f32x16 s[2];
    if (do_tile) {
#pragma unroll
      for (int kb = 0; kb < 2; ++kb) {
#pragma unroll
        for (int i = 0; i < 16; ++i) s[kb][i] = 0.f;
#pragma unroll
        for (int ks = 0; ks < DK / 16; ++ks) {
          const bf16x8 kf = *(const bf16x8*)(Ks + (kb * 32 + r) * KS + ks * 16 + g * 8);
          s[kb] = MFMA(kf, qf[ks], s[kb]);
          if ((ks & 3) == 3) __builtin_amdgcn_sched_barrier(0);
        }
      }
    }
    if (do_tile) {
      bool need_mask = false;
      if constexpr (MODE == 0) need_mask = (k0 + 64 > a.Tk);
      if constexpr (MODE == 1) need_mask = (k0 + 63 > wq_lo);
      float tmax = -1e30f;
      if constexpr (MODE == 1) {
#pragma unroll
        for (int kb = 0; kb < 2; ++kb)
#pragma unroll
          for (int j = 0; j < 4; ++j) {
            const float4 cb = *(const float4*)(Cs + kb * 32 + 8 * j + 4 * g);
            s[kb][4 * j + 0] = fmaf(s[kb][4 * j + 0], sc, cq2 - cb.x);
            s[kb][4 * j + 1] = fmaf(s[kb][4 * j + 1], sc, cq2 - cb.y);
            s[kb][4 * j + 2] = fmaf(s[kb][4 * j + 2], sc, cq2 - cb.z);
            s[kb][4 * j + 3] = fmaf(s[kb][4 * j + 3], sc, cq2 - cb.w);
          }
      }
      if (need_mask) {
#pragma unroll
        for (int kb = 0; kb < 2; ++kb)
#pragma unroll
          for (int j = 0; j < 4; ++j)
#pragma unroll
            for (int i = 0; i < 4; ++i) {
              const int key = k0 + kb * 32 + 8 * j + 4 * g + i;
              bool ok = true;
              if constexpr (MODE == 0) ok = key < a.Tk;
              if constexpr (MODE == 1) ok = key <= qpos;
              s[kb][4 * j + i] = ok ? s[kb][4 * j + i] : -1e30f;
            }
      }
#pragma unroll
      for (int kb = 0; kb < 2; ++kb)
#pragma unroll
        for (int i = 0; i < 16; ++i) tmax = fmaxf(tmax, s[kb][i]);
      if constexpr (MODE != 1) tmax *= sc;
      tmax = half_max(tmax);
      const float mnew = fmaxf(mrun, tmax);
      const float alpha = ex2(mrun - mnew);
      const bool changed = mnew != mrun;
      mrun = mnew;
      typedef float f32x2 __attribute__((ext_vector_type(2)));
      f32x2 ps2 = {0.f, 0.f};
      const f32x2 sc2 = {sc, sc}, nm2 = {-mnew, -mnew};
#pragma unroll
      for (int kb = 0; kb < 2; ++kb)
#pragma unroll
        for (int i = 0; i < 16; i += 2) {
          f32x2 a2 = {s[kb][i], s[kb][i + 1]};
          if constexpr (MODE == 1) a2 = a2 + nm2; else a2 = __builtin_elementwise_fma(a2, sc2, nm2);
          f32x2 p2 = {ex2(a2.x), ex2(a2.y)};
          s[kb][i] = p2.x; s[kb][i + 1] = p2.y;
          ps2 = ps2 + p2;
        }
      const float psum = ps2.x + ps2.y;
      lsum = lsum * alpha + psum;
      if (__builtin_amdgcn_ballot_w64(changed) != 0ull) {
#pragma unroll
        for (int db = 0; db < DV / 32; ++db)
#pragma unroll
          for (int i = 0; i < 16; ++i) o[db][i] *= alpha;
      }
#pragma unroll
      for (int kb = 0; kb < 2; ++kb)
#pragma unroll
        for (int u = 0; u < 2; ++u) {
          const unsigned p0 = pk2(s[kb][8 * u + 0], s[kb][8 * u + 1]), p1 = pk2(s[kb][8 * u + 2], s[kb][8 * u + 3]);
          const unsigned p2 = pk2(s[kb][8 * u + 4], s[kb][8 * u + 5]), p3 = pk2(s[kb][8 * u + 6], s[kb][8 * u + 7]);
          const bf16x8 pf = __builtin_bit_cast(bf16x8, make_uint4(p0, p1, p2, p3));
#pragma unroll
          for (int db = 0; db < DV / 32; ++db) {
            const bf16x8 vf = *(const bf16x8*)(Vs + (db * 32 + r) * VS + kb * 32 + 16 * u + 8 * g);
            o[db] = MFMA(vf, pf, o[db]);
          }
          __builtin_amdgcn_sched_barrier(0);
        }
    }
    __syncthreads();
  }
  if (wave_active) {
    const float ltot = half_sum(lsum);
    const float inv = 1.f / ltot;
    if (ql < a.nq && !a.dry) {
      u16* gp = a.gate + (size_t)qrow * GLD;
#pragma unroll
      for (int db = 0; db < DV / 32; ++db)
#pragma unroll
        for (int j = 0; j < 4; ++j) {
          const int d = db * 32 + 8 * j + 4 * g;
          const uint2 gv = *(const uint2*)(gp + d);
          st4bf(gp + d, o[db][4 * j] * inv * bflo(gv.x), o[db][4 * j + 1] * inv * bfhi(gv.x),
                o[db][4 * j + 2] * inv * bflo(gv.y), o[db][4 * j + 3] * inv * bfhi(gv.y));
        }
    }
  }
}

DI float wave_sum(float v) {
#pragma unroll
  for (int o = 32; o > 0; o >>= 1) v += __shfl_xor(v, o);
  return v;
}
DI void lat_rows(const Params& p, int l, int row0, int nrows) {
  const int t_ = tid(); const int lane = t_ & 63, w = t_ >> 6;
  const f32x4 gv = *(const f32x4*)(p.kvn_g + l * 256 + lane * 4);
  f32x4 v[8];
#pragma unroll
  for (int k = 0; k < 8; ++k) {
    const int row = row0 + w + 8 * k;
    const float* d = row < MP ? p.out + O_PLAT + (size_t)l * MP * 256 + (size_t)row * 256 : p.out + O_SLAT + (size_t)l * MS * 256 + (size_t)(row - MP) * 256;
    v[k] = *(const f32x4*)(d + lane * 4);
  }
#pragma unroll
  for (int k = 0; k < 8; ++k) {
    const int row = row0 + w + 8 * k;
    float* d = row < MP ? p.out + O_PLAT + (size_t)l * MP * 256 + (size_t)row * 256 : p.out + O_SLAT + (size_t)l * MS * 256 + (size_t)(row - MP) * 256;
    const float ss = wave_sum(v[k].x * v[k].x + v[k].y * v[k].y + v[k].z * v[k].z + v[k].w * v[k].w);
    const float rs = rsqrtf(ss * (1.f / 256.f) + EPS);
    *(f32x4*)(d + lane * 4) = v[k] * rs * gv;
  }
}
DI void ln_rows(const Params& p, int l, int row0, int nrows) {
  const int t_ = tid(); const int lane = t_ & 63, w = t_ >> 6;
  u16* Xb = (u16*)(p.ws + W_XB);
  f32x4 v[4][4], gg[4], bb[4];
#pragma unroll
  for (int k = 0; k < 4; ++k)
#pragma unroll
    for (int i = 0; i < 4; ++i) v[k][i] = *(const f32x4*)(p.out + O_Y + (size_t)(row0 + w + 8 * k) * 1024 + i * 256 + lane * 4);
#pragma unroll
  for (int i = 0; i < 4; ++i) { gg[i] = *(const f32x4*)(p.ln_g + l * 1024 + i * 256 + lane * 4); bb[i] = *(const f32x4*)(p.ln_b + l * 1024 + i * 256 + lane * 4); }
#pragma unroll
  for (int k = 0; k < 4; ++k) {
    const int row = row0 + w + 8 * k;
    float* d = p.out + O_Y + (size_t)row * 1024;
    float s = 0.f;
#pragma unroll
    for (int i = 0; i < 4; ++i) s += v[k][i].x + v[k][i].y + v[k][i].z + v[k][i].w;
    const float mu = wave_sum(s) * (1.f / 1024.f);
    float q = 0.f;
#pragma unroll
    for (int i = 0; i < 4; ++i) { v[k][i] = v[k][i] - mu; q += v[k][i].x * v[k][i].x + v[k][i].y * v[k][i].y + v[k][i].z * v[k][i].z + v[k][i].w * v[k][i].w; }
    const float rstd = rsqrtf(wave_sum(q) * (1.f / 1024.f) + EPS);
#pragma unroll
    for (int i = 0; i < 4; ++i) {
      const f32x4 y = v[k][i] * rstd * gg[i] + bb[i];
      *(f32x4*)(d + i * 256 + lane * 4) = y;
      if (l == 0) st4bf(Xb + (size_t)row * 1024 + i * 256 + lane * 4, y.x, y.y, y.z, y.w);
    }
  }
}
DI void cumsum_item(const Params& p, int l, int idx, char* smem) {
  float* sw = (float*)smem;
  const int t = tid(), lane = t & 63, w = t >> 6;
  const bool samp = idx >= 16;
  const int bh = samp ? idx - 16 : idx, b = bh >> 2, h = bh & 3;
  const int t0 = t * 8;
  float v[8];
#pragma unroll
  for (int j = 0; j < 8; ++j) {
    const int tt = t0 + j;
    float x = 0.f;
    if (!samp) x = p.out[O_PLOGF + (size_t)l * MP * 4 + (size_t)(b * 4096 + tt) * 4 + h];
    else if (tt < PAST) x = p.c_logf[(size_t)l * BS * PAST * 4 + (size_t)(b * PAST + tt) * 4 + h];
    else if (tt < TKS) x = p.out[O_SLOGF + (size_t)l * MS * 4 + (size_t)(b * 16 + tt - PAST) * 4 + h];
    v[j] = x;
  }
#pragma unroll
  for (int j = 1; j < 8; ++j) v[j] += v[j - 1];
  float tot = v[7], inc = tot;
#pragma unroll
  for (int o = 1; o < 64; o <<= 1) { const float n = __shfl_up(inc, o); if (lane >= o) inc += n; }
  if (lane == 63) sw[w] = inc;
  __syncthreads();
  float base = inc - tot;
  for (int i = 0; i < w; ++i) base += sw[i];
  float* dst = samp ? (float*)(p.ws + W_CUMS) + (size_t)bh * TAS : (float*)(p.ws + W_CUMP) + (size_t)bh * 4096;
  const int tmax = samp ? TAS : 4096;
  if (t0 < tmax) {
#pragma unroll
    for (int j = 0; j < 8; j += 4) *(float4*)(dst + t0 + j) = make_float4(base + v[j], base + v[j + 1], base + v[j + 2], base + v[j + 3]);
  }
}

DI void phase_p1(const Params& p, int l, unsigned* ctr, int* s_item, char* smem) {
  phase_cacheconv(p, l);
  const int NT = N1 / 256;
  const u16* Xb = (const u16*)(p.ws + W_XB);
  const u16* Wt = (const u16*)(p.ws + W_WIN) + (size_t)l * N1 * 1024;
  const int n_mem = (l == 0) ? 2 : 0;
  FOR_QUEUES(q, j, q_mtiles(q, 65) * NT + n_mem)
    const int kq = q_mtiles(q, 65), n_h = kq * NT;
    if (j < n_h) {
      const int nt = j / kq, ml = j - nt * kq;
      const int mt = q + 8 * ml;
      gemm8_h_tile(p, l, Wt, 1024, Xb, 1024, 1024, nt * 256, mt * 256, smem);
    } else {
      const int jj = q * 2 + (j - n_h), l2 = jj >> 3, mt = (jj >> 1) & 3, nt = jj & 1;
      gemm_tile<false, false, EPI_MEMKV>(p, l2, p.ws + W_MEMB, 1024, (const u16*)(p.ws + W_WMKV) + (size_t)l2 * 512 * 1024, 1024, 1024, mt * 256, nt * 256, smem, 1024);
    }
  END_QUEUES
}
DI void phase_p3(const Params& p, int l, unsigned* ctr, int* s_item, char* smem, bool skip_lat = false) {
  FOR_QUEUES(q, j, 6 + 8 * 4 + q_mtiles(q, 65) * 7 + (258 - q + 7) / 8)
    const int kq = q_mtiles(q, 65);
    const int e0 = 6, e1 = e0 + 8 * 4, e2 = e1 + kq * 4, e3 = e2 + kq * 3;
    if (j < e0) cumsum_item(p, l, q * 6 + j, smem);
    else if (j < e1) {
      const int jj = j - e0, mt = q + 8 * (jj >> 2), nt = jj & 3;
      gemm8_kv_tile<true>(p, l, (const u16*)(p.ws + W_WUKV) + (size_t)l * 1024 * 256, (const u16*)(p.ws + W_LATC), nt * 256, mt * 256, smem);
    } else if (j < e2) {
      const int jj = j - e1, mt = q + 8 * (jj >> 2), nt = jj & 3;
      gemm8_kv_tile<false>(p, l, (const u16*)(p.ws + W_WUKVF) + (size_t)l * 1024 * 256, (const u16*)(p.ws + W_CKV), nt * 256, mt * 256, smem);
    } else if (j < e3) {
      const int jj = j - e2, mt = q + 8 * (jj / 3), nt = jj % 3;
      gemm_tile<false, true, EPI_Q>(p, l, p.ws + W_CQ, 384, (const u16*)(p.ws + W_WUQ) + (size_t)l * 768 * 384, 384, 384, mt * 256, nt * 256, smem, MT);
    } else if (!skip_lat) lat_rows(p, l, (q + 8 * (j - e3)) * 64, 64);
  END_QUEUES
}
DI void phase_p4(const Params& p, int l, unsigned* ctr, int* s_item, char* smem, int dry = 0) {
  char* ws = p.ws;
  const float sc_mla = 0.07216878364870322f * LOG2E, sc_64 = 0.125f * LOG2E;
  unsigned* barw = (unsigned*)(p.ws + W_BAR);
  FOR_QUEUES(q, j, 108 + ((q < 4 && !dry) ? 1 : 0))
    if (j >= 108) {
      if (threadIdx.x == 0) {
        XB_SPIN(xb_ld(barw + XB_SCNT(l)) < 96u, barw);
        __builtin_amdgcn_fence(__ATOMIC_ACQUIRE, "agent");
        asm volatile("s_waitcnt vmcnt(0)" ::: "memory");
      }
      __syncthreads();
      gemm8_out_tile(p, l, (const u16*)(ws + W_WOUT) + (size_t)l * 1024 * GLD, GLD, (const u16*)(ws + W_GATE), GLD, 1024, q * 256, 64 * 256, smem, MT);
    } else {
    int it, b, h, qb = 0;
    if (j < 12) { it = j < 4 ? 0 : (j < 8 ? 32 : 1600); b = q; h = j & 3; }
    else if (j < 76) { const int jj = j - 12; it = jj < 32 ? 64 : 576; const int k = jj & 31; qb = 15 - (k >> 1); const int bh = q + 8 * (k & 1); b = bh >> 2; h = bh & 3; }
    else { const int k = j - 76; it = 1088; qb = k >> 1; const int bh = q + 8 * (k & 1); b = bh >> 2; h = bh & 3; }
    AttnItem a;
    a.k2 = nullptr; a.cum = nullptr; a.dry = dry;
    if (it < 32 || (it >= 64 && it < 576)) {
      const bool samp = it < 32;
      const int T = samp ? TAS : 4096;
      a.q = (const u16*)(ws + W_XB) + h * 192; a.ldq = 768;
      a.k1 = (const u16*)(ws + (samp ? W_KNS : W_KNP)) + (size_t)(b * 4 + h) * T * 128; a.ldk1 = 128;
      a.k2 = (const u16*)(ws + (samp ? W_KRBS : W_KRBP)) + (size_t)b * T * 64;
      a.vt = (const u16*)(ws + (samp ? W_VTS : W_VTP)) + (size_t)(b * 4 + h) * 128 * T; a.ldv = T;
      a.gate = (u16*)(ws + W_GATE) + h * 128;
      if (samp) { a.qrow0 = MP + b * 16; a.nq = 16; a.qpos0 = PAST; a.Tk = TKS; a.ntiles = 33; }
      else { a.qrow0 = b * 4096 + qb * 256; a.nq = 256; a.qpos0 = qb * 256; a.Tk = 4096; a.ntiles = 4 * qb + 4; }
      attn_item<192, 128, 0>(a, sc_mla, smem);
    } else if (it < 64 || it < 1088) {
      const bool samp = it < 64;
      const int T = samp ? TAS : 4096;
      a.q = (const u16*)(ws + W_FQ) + h * 64; a.ldq = 256;
      a.k1 = (const u16*)(ws + (samp ? W_FKBS : W_FKBP)) + (size_t)b * T * 256 + h * 64; a.ldk1 = 256;
      a.vt = (const u16*)(ws + (samp ? W_FVTS : W_FVTP)) + (size_t)(b * 4 + h) * 64 * T; a.ldv = T;
      a.cum = (const float*)(ws + (samp ? W_CUMS : W_CUMP)) + (size_t)(b * 4 + h) * T;
      a.gate = (u16*)(ws + W_GATE) + 512 + h * 64;
      if (samp) { a.qrow0 = MP + b * 16; a.nq = 16; a.qpos0 = PAST; a.Tk = TKS; a.ntiles = 33; }
      else { a.qrow0 = b * 4096 + qb * 256; a.nq = 256; a.qpos0 = qb * 256; a.Tk = 4096; a.ntiles = 4 * qb + 4; }
      attn_item<64, 64, 1>(a, sc_64, smem);
    } else {
      const bool samp = it >= 1600;
      a.q = (const u16*)(ws + W_MQ) + h * 64; a.ldq = 256;
      a.k1 = (samp ? (const u16*)(ws + W_MEMKS) : (const u16*)(ws + W_MEMKP) + (size_t)l * 1024 * 256) + (size_t)b * NMEM * 256 + h * 64; a.ldk1 = 256;
      a.vt = (samp ? (const u16*)(ws + W_MEMVTS) : (const u16*)(ws + W_MEMVTP) + (size_t)l * 1024 * 256) + (size_t)(b * 4 + h) * 64 * NMEM; a.ldv = NMEM;
      a.gate = (u16*)(ws + W_GATE) + 768 + h * 64;
      a.Tk = NMEM; a.ntiles = 4; a.qpos0 = 0;
      if (samp) { a.qrow0 = MP + b * 16; a.nq = 16; } else { a.qrow0 = b * 4096 + qb * 256; a.nq = 256; }
      attn_item<64, 64, 2>(a, sc_64, smem);
    }
    if ((it == 0 || it == 32 || it == 1600) && !dry) {
      asm volatile("s_waitcnt vmcnt(0)" ::: "memory");
      __syncthreads();
      if (threadIdx.x == 0) {
        __builtin_amdgcn_fence(__ATOMIC_RELEASE, "agent");
        asm volatile("s_waitcnt vmcnt(0)" ::: "memory");
        (void)xb_add(barw + XB_SCNT(l), 1u);
      }
    }
    }
  END_QUEUES
}
DI void phase_p5(const Params& p, int l, unsigned* ctr, int* s_item, char* smem) {
  FOR_QUEUES(q, j, 8 * 4)
    const int kq = 8;
    const int nt = j / kq, ml = j - nt * kq;
    const int mt = q + 8 * ml;
    gemm8_out_tile(p, l, (const u16*)(p.ws + W_WOUT) + (size_t)l * 1024 * GLD, GLD, (const u16*)(p.ws + W_GATE), GLD, 1024, nt * 256, mt * 256, smem, MT);
  END_QUEUES
}
DI void phase_p6(const Params& p, int l, unsigned* ctr, int* s_item) {
  FOR_QUEUES(q, j, (516 - q + 7) / 8)
    ln_rows(p, l, (q + 8 * j) * 32, 32);
  END_QUEUES
}

__global__ void __launch_bounds__(512, 2) mega_kernel(Params p, int ph_begin, int ph_end) {
  __shared__ __attribute__((aligned(16))) char smem_all[SMEM_BYTES + 32];
  char* smem = smem_all;
  uint4& xb_words = *(uint4*)(smem_all + SMEM_BYTES);
  int& s_item = *(int*)(smem_all + SMEM_BYTES + 16);
  unsigned* bar = (unsigned*)(p.ws + W_BAR);
  if (threadIdx.x == 0) xb_words = make_uint4(0u, 0u, 0u, 0u);
  __syncthreads();
  XcdBarrier xb;
  const bool multi = (ph_end - ph_begin) > 1;
  if (multi) xb = xcd_barrier_post(bar, (volatile LAS unsigned*)&xb_words);
  for (int ph = ph_begin; ph < ph_end; ++ph) {
    unsigned* ctr = bar + XB_CTR(ph);
    if (ph == 0) phase_prep(p);
    else {
      const int l = (ph - 1) / 5, k = (ph - 1) % 5;
      if (k == 0) phase_p1(p, l, ctr, &s_item, smem);
      else if (k == 1) phase_p3(p, l, ctr, &s_item, smem);
      else if (k == 2) phase_p4(p, l, ctr, &s_item, smem);
      else if (k == 3) phase_p5(p, l, ctr, &s_item, smem);
      else phase_p6(p, l, ctr, &s_item);
    }
#if PROBE_KIND >= 0
    if (ph > 0 && (ph - 1) % 5 == PROBE_KIND && multi) {
      xcd_barrier(xb);
      const int l = (ph - 1) / 5;
      unsigned* ctr2 = bar + XB_CTR(ph + 16);
      if (PROBE_KIND == 0) phase_p1(p, l, ctr2, &s_item, smem);
      else if (PROBE_KIND == 1) phase_p3(p, l, ctr2, &s_item, smem, true);
      else if (PROBE_KIND == 2) phase_p4(p, l, ctr2, &s_item, smem, p.pad + 1);
      else if (PROBE_KIND == 3 && l == 0) phase_p5(p, l, ctr2, &s_item, smem);
    }
#endif
    if (ph + 1 < ph_end) {
      if (p.use_cg) cg::this_grid().sync();
      else xcd_barrier(xb);
    }
  }
}

extern "C" void kernel_launch(void* const* d_in, const int* in_sizes, int n_in, void* d_out, int out_size, void* d_ws,
                              size_t ws_size, hipStream_t stream) {
  Params p{};
  p.x_prompt = (const float*)d_in[0]; p.x_sample = (const float*)d_in[1];
  p.c_lat = (const float*)d_in[2]; p.c_kr = (const float*)d_in[3]; p.c_fk = (const float*)d_in[4]; p.c_fv = (const float*)d_in[5];
  p.c_logf = (const float*)d_in[6]; p.c_mk = (const float*)d_in[7]; p.c_mv = (const float*)d_in[8];
  p.mem_prompt = (const float*)d_in[9]; p.w_in = (const float*)d_in[10]; p.b_f = (const float*)d_in[11];
  p.qn_g = (const float*)d_in[12]; p.kvn_g = (const float*)d_in[13]; p.w_uq = (const float*)d_in[14]; p.w_ukv = (const float*)d_in[15];
  p.w_memkv = (const float*)d_in[16]; p.w_out = (const float*)d_in[17]; p.ln_g = (const float*)d_in[18]; p.ln_b = (const float*)d_in[19];
  p.out = (float*)d_out; p.ws = (char*)d_ws; p.use_cg = 0; p.pad = 0;
  static int grid_blocks = 0;
  if (!grid_blocks) {
    int dev = 0, cus = 0, per_cu = 0;
    hipGetDevice(&dev);
    hipDeviceGetAttribute(&cus, hipDeviceAttributeMultiprocessorCount, dev);
    hipOccupancyMaxActiveBlocksPerMultiprocessor(&per_cu, mega_kernel, NTH, 0);
    if (per_cu > 1) per_cu = 1;
    if (per_cu < 1) per_cu = 1;
    grid_blocks = cus * per_cu;
  }
  hipMemsetAsync((char*)d_ws + W_BAR, 0, BAR_BYTES, stream);
#if MK_LAUNCHES == 1
  int b = 0, e = NPH;
  void* args[] = {&p, &b, &e};
  hipError_t err = hipLaunchCooperativeKernel((const void*)mega_kernel, dim3(grid_blocks), dim3(NTH), args, 0, stream);
  if (err != hipSuccess) fprintf(stderr, "cooperative launch failed: %s (grid %d)\n", hipGetErrorString(err), grid_blocks);
#else
  for (int ph = 0; ph < NPH; ++ph) mega_kernel<<<dim3(grid_blocks), dim3(NTH), 0, stream>>>(p, ph, ph + 1);
#endif
}
```
